# Optimizing an MI355X kernel written in HIP

```python
import jax, jax.numpy as jnp
from jax import lax
import numpy as np

D_MODEL = 1024
BATCH = 8
SEQ = 2048
DEPTH = 1

N_META = 16
CHUNK = 128
D_MIX = 2 * D_MODEL
RET_WIDTH = D_MIX // 2
RET_HEADS = 4
RET_DV = RET_WIDTH // RET_HEADS
RET_DK = RET_DV // 2
FOX_WIDTH = D_MIX - RET_WIDTH
FOX_HEAD_DIM = 64
FOX_HEADS = FOX_WIDTH // FOX_HEAD_DIM
ROPE_BASE = 10000.0
EPS = 1e-6
NEG_INF = -1e30
SPLIT_SIZES = (RET_HEADS * RET_DK, RET_HEADS * RET_DK, RET_WIDTH, RET_WIDTH,
               FOX_WIDTH, FOX_WIDTH, FOX_WIDTH, FOX_WIDTH, FOX_HEADS)
D_IN_PROJ = 2 * RET_HEADS * RET_DK + 2 * RET_WIDTH + 4 * FOX_WIDTH + FOX_HEADS

kernel_name = "hymba_retention_fox_hybrid"


def rmsnorm(x, g):
    xf = x.astype(jnp.float32)
    y = xf * lax.rsqrt(jnp.mean(xf * xf, axis=-1, keepdims=True) + EPS)
    return (y * g.astype(jnp.float32)).astype(x.dtype)


def head_rmsnorm(x):
    xf = x.astype(jnp.float32)
    y = xf * lax.rsqrt(jnp.mean(xf * xf, axis=-1, keepdims=True) + EPS)
    return y.astype(x.dtype)


def rotary(x, pos):
    d = x.shape[-1]
    inv = ROPE_BASE ** (-jnp.arange(0, d, 2, dtype=jnp.float32) / d)
    ang = pos[:, None] * inv[None, :]
    cos = jnp.cos(ang)[None, :, None, :]
    sin = jnp.sin(ang)[None, :, None, :]
    xf = x.astype(jnp.float32)
    x1, x2 = xf[..., : d // 2], xf[..., d // 2:]
    out = jnp.concatenate([x1 * cos - x2 * sin, x1 * sin + x2 * cos], axis=-1)
    return out.astype(x.dtype)


def retention_chunkwise(q, k, v):
    b, t, h, dk = q.shape
    dv = v.shape[-1]
    nc = t // CHUNK
    log_gamma = jnp.log1p(-jnp.exp2(-5.0 - jnp.arange(h, dtype=jnp.float32)))
    q = q.reshape(b, nc, CHUNK, h, dk)
    k = k.reshape(b, nc, CHUNK, h, dk)
    v = v.reshape(b, nc, CHUNK, h, dv)
    idx = jnp.arange(CHUNK, dtype=jnp.float32)
    diff = idx[:, None] - idx[None, :]
    dmask = jnp.where(diff[None] >= 0,
                      jnp.exp(log_gamma[:, None, None] * jnp.maximum(diff, 0.0)[None]),
                      0.0)
    scores = jnp.einsum('bnchk,bnshk->bnhcs', q, k) * dmask.astype(q.dtype)
    out_intra = jnp.einsum('bnhcs,bnshv->bnchv', scores, v)
    zeta = jnp.exp(log_gamma[:, None] * (CHUNK - 1.0 - idx)[None, :])
    kv = jnp.einsum('bnchk,bnchv,hc->nbhkv', k, v, zeta.astype(k.dtype)).astype(jnp.float32)
    chunk_decay = jnp.exp(log_gamma * CHUNK)[None, :, None, None]

    def step(state, kv_i):
        return state * chunk_decay + kv_i, state

    _, s_prev = lax.scan(step, jnp.zeros((b, h, dk, dv), jnp.float32), kv)
    xi = jnp.exp(log_gamma[:, None] * (idx + 1.0)[None, :])
    out_inter = jnp.einsum('bnchk,nbhkv,hc->bnchv', q, s_prev.astype(q.dtype), xi.astype(q.dtype))
    return (out_intra + out_inter).reshape(b, t, h, dv)


def forgetting_attention(q, k, v, log_f, valid):
    b, t, h, d = q.shape
    c = jnp.cumsum(log_f, axis=1).transpose(0, 2, 1)
    scale = d ** -0.5
    outs = []
    for i in range(t // CHUNK):
        lo, hi = i * CHUNK, (i + 1) * CHUNK
        s = jnp.einsum('bthd,bshd->bhts', q[:, lo:hi], k[:, :hi]).astype(jnp.float32) * scale
        s = s + (c[:, :, lo:hi, None] - c[:, :, None, :hi])
        tpos = jnp.arange(lo, hi)
        spos = jnp.arange(hi)
        mask = (spos[None, :] <= tpos[:, None]) & valid[None, :hi]
        s = jnp.where(mask[None, None], s, NEG_INF)
        p = jax.nn.softmax(s, axis=-1)
        outs.append(jnp.einsum('bhts,bshd->bthd', p.astype(v.dtype), v[:, :hi]))
    return jnp.concatenate(outs, axis=1)


def hybrid_layer(h_res, norm_g, w_in, b_f, w_out):
    b, l, _ = h_res.shape
    pad = CHUNK - N_META
    t = l + pad
    u = rmsnorm(h_res, norm_g)
    u = jnp.pad(u, ((0, 0), (pad, 0), (0, 0)))
    z = u @ w_in
    offsets = np.cumsum(SPLIT_SIZES)[:-1].tolist()
    rq, rk, rv, rg, fq, fk, fv, fg, ff = jnp.split(z, offsets, axis=-1)
    pos = jnp.arange(t, dtype=jnp.float32) - pad
    valid = jnp.arange(t) >= pad
    rq = rotary(rq.reshape(b, t, RET_HEADS, RET_DK), pos)
    rk = rotary(rk.reshape(b, t, RET_HEADS, RET_DK), pos) * (RET_DK ** -0.5)
    y_r = retention_chunkwise(rq, rk, rv.reshape(b, t, RET_HEADS, RET_DV))
    y_r = head_rmsnorm(y_r).reshape(b, t, RET_WIDTH) * jax.nn.silu(rg)
    log_f = jnp.where(valid[None, :, None],
                      jax.nn.log_sigmoid((ff + b_f).astype(jnp.float32)), 0.0)
    y_f = forgetting_attention(fq.reshape(b, t, FOX_HEADS, FOX_HEAD_DIM),
                               fk.reshape(b, t, FOX_HEADS, FOX_HEAD_DIM),
                               fv.reshape(b, t, FOX_HEADS, FOX_HEAD_DIM),
                               log_f, valid)
    y_f = y_f.reshape(b, t, FOX_WIDTH) * jax.nn.silu(fg)
    y = jnp.concatenate([y_r, y_f], axis=-1)[:, pad:]
    return h_res + y @ w_out


def setup_inputs(seed: int = 0) -> dict:
    key = jax.random.key(seed)
    k = jax.random.split(key, 7)
    x = jax.random.normal(k[0], (BATCH, SEQ, D_MODEL), jnp.float32)
    meta_tokens = jax.random.normal(k[1], (N_META, D_MODEL), jnp.float32)
    norm_g = 1.0 + 0.02 * jax.random.normal(k[2], (DEPTH, D_MODEL), jnp.float32)
    w_in = jax.random.normal(k[3], (DEPTH, D_MODEL, D_IN_PROJ), jnp.float32) * D_MODEL ** -0.5
    b_f = jax.random.uniform(k[4], (DEPTH, FOX_HEADS), jnp.float32, 1.0, 4.0)
    w_out = jax.random.normal(k[5], (DEPTH, D_MIX, D_MODEL), jnp.float32) * D_MIX ** -0.5
    final_g = 1.0 + 0.02 * jax.random.normal(k[6], (D_MODEL,), jnp.float32)
    return {"x": x, "meta_tokens": meta_tokens, "norm_g": norm_g, "w_in": w_in,
            "b_f": b_f, "w_out": w_out, "final_g": final_g}


def reference(x, meta_tokens, norm_g, w_in, b_f, w_out, final_g):
    b = x.shape[0]
    meta = jnp.broadcast_to(meta_tokens[None].astype(x.dtype), (b, N_META, D_MODEL))
    h = jnp.concatenate([meta, x], axis=1)
    for layer in range(DEPTH):
        h = hybrid_layer(h, norm_g[layer], w_in[layer], b_f[layer], w_out[layer])
    return rmsnorm(h[:, N_META:], final_g)
```

```cpp
#include <hip/hip_runtime.h>
#include <hip/hip_cooperative_groups.h>
#include <stdint.h>
#include <stdio.h>
#include <type_traits>
namespace cg = cooperative_groups;

typedef __attribute__((ext_vector_type(8))) short bf16x8;
typedef __attribute__((ext_vector_type(16))) float f32x16;
typedef __attribute__((ext_vector_type(4))) float f32x4;
typedef __attribute__((ext_vector_type(2))) float f32x2;
typedef __attribute__((ext_vector_type(2))) __bf16 bf2_t;
typedef unsigned short bf16_t;
#define LOG2E_F 1.4426950408889634f

#define DI __device__ __forceinline__

constexpr int BATCH = 8, SEQ = 2048, DM = 1024, NMETA = 16, LTOK = 2064;
constexpr int MSEQ = BATCH * SEQ;
constexpr int MROWS = MSEQ + NMETA;
constexpr int NIN = 7184;
constexpr int NMAIN = 7168;
constexpr float EPS = 1e-6f;
constexpr float LOG2E = 1.4426950408889634f;
constexpr float QSCALE = 0.125f * LOG2E;
constexpr float DKS = 0.08838834764831845f;
constexpr float BIG = 1e30f;
constexpr int PCENTER = 1032;

constexpr size_t al256(size_t x) { return (x + 255) & ~(size_t)255; }
constexpr size_t OFF_RQ = 0;
constexpr size_t OFF_RK = al256(OFF_RQ + (size_t)MSEQ * 512 * 2);
constexpr size_t OFF_RVT = al256(OFF_RK + (size_t)MROWS * 512 * 2);
constexpr size_t OFF_RVTM = al256(OFF_RVT + (size_t)BATCH * 4 * 256 * 2048 * 2);
constexpr size_t OFF_RG = al256(OFF_RVTM + (size_t)4 * 256 * 16 * 2);
constexpr size_t OFF_FQ = al256(OFF_RG + (size_t)MSEQ * 1024 * 2);
constexpr size_t OFF_FK = al256(OFF_FQ + (size_t)MSEQ * 1024 * 2);
constexpr size_t OFF_FVT = al256(OFF_FK + (size_t)MROWS * 1024 * 2);
constexpr size_t OFF_FVTM = al256(OFF_FVT + (size_t)BATCH * 16 * 64 * 2048 * 2);
constexpr size_t OFF_FG = al256(OFF_FVTM + (size_t)16 * 64 * 16 * 2);
constexpr size_t OFF_LF = al256(OFF_FG + (size_t)MSEQ * 1024 * 2);
constexpr size_t OFF_LFM = al256(OFF_LF + (size_t)BATCH * 16 * 2048 * 4);
constexpr size_t OFF_WOT = al256(OFF_LFM + 16 * 16 * 4);
constexpr size_t OFF_COS = al256(OFF_WOT + (size_t)1024 * 2048 * 2);
constexpr size_t OFF_SIN = al256(OFF_COS + (size_t)LTOK * 64 * 4);
constexpr size_t OFF_CTR = al256(OFF_SIN + (size_t)LTOK * 64 * 4);
constexpr size_t OFF_XB = al256(OFF_CTR + 1024);
constexpr size_t OFF_EXCH = al256(OFF_XB + 16384);
constexpr size_t WS_END = OFF_EXCH + (size_t)64 * 8 * 256 * 4;
constexpr size_t OUT_U = 0;
constexpr size_t OUT_WINT = al256((size_t)MROWS * 1024 * 2);
static_assert(OUT_WINT + (size_t)NIN * 1024 * 2 <= (size_t)MSEQ * 1024 * 4, "d_out scratch overflow");
static_assert(WS_END <= (size_t)256 * 1024 * 1024, "workspace overflow");

constexpr int SMEM_BYTES = 73728 + 1024;

struct Params {
  const float* x; const float* meta; const float* norm_g; const float* w_in; const float* b_f; const float* w_out; const float* final_g;
  float* out; unsigned char* ws;
};

DI unsigned pack2(float a, float b) { f32x2 v = {a, b}; bf2_t r = __builtin_convertvector(v, bf2_t); return __builtin_bit_cast(unsigned, r); }
DI bf16_t f2bf(float a) { return (bf16_t)(pack2(a, 0.f) & 0xffffu); }
DI float bflo(unsigned u) { return __uint_as_float(u << 16); }
DI float bfhi(unsigned u) { return __uint_as_float(u & 0xffff0000u); }
DI float silu(float v) { return v * __builtin_amdgcn_rcpf(1.f + __builtin_amdgcn_exp2f(-LOG2E_F * v)); }
DI float wave_sum(float v) {
#pragma unroll
  for (int o = 32; o > 0; o >>= 1) v += __shfl_xor(v, o);
  return v;
}
DI f32x16 zero16() { f32x16 z;
#pragma unroll
  for (int i = 0; i < 16; ++i) z[i] = 0.f; return z; }
#define MFMA32(a, b, c) __builtin_amdgcn_mfma_f32_32x32x16_bf16((a), (b), (c), 0, 0, 0)
#define MFMA16(a, b, c) __builtin_amdgcn_mfma_f32_16x16x32_bf16((a), (b), (c), 0, 0, 0)
DI float xhalf_max(float v) { const unsigned u = __float_as_uint(v); auto r = __builtin_amdgcn_permlane32_swap(u, u, false, false); return fmaxf(__uint_as_float(r[0]), __uint_as_float(r[1])); }
DI float xhalf_sum(float v) { const unsigned u = __float_as_uint(v); auto r = __builtin_amdgcn_permlane32_swap(u, u, false, false); return __uint_as_float(r[0]) + __uint_as_float(r[1]); }
DI float lg2gamma(int h) { return log2f(1.f - exp2f(-5.f - (float)h)); }

DI void transpose_to_bf16(const float* __restrict__ src, bf16_t* __restrict__ dst, int K, int N, float* tile  ) {
  const int tid = threadIdx.x;
  const int kts = K / 64, nts = (N + 63) / 64, ntile = kts * nts;
  const int r0 = tid >> 4, c4 = tid & 15;
  float4 v[4];
  auto load = [&](int t) {
    const int kt = t % kts, nt = t / kts;
    const int n = nt * 64 + c4 * 4;
#pragma unroll
    for (int ps = 0; ps < 4; ++ps) {
      v[ps] = make_float4(0.f, 0.f, 0.f, 0.f);
      if (n < N) { const f32x4 t_ = __builtin_nontemporal_load((const f32x4*)(src + (size_t)(kt * 64 + r0 + 16 * ps) * N + n)); v[ps] = make_float4(t_[0], t_[1], t_[2], t_[3]); }
    }
  };
  int t = blockIdx.x;
  if (t < ntile) load(t);
  for (; t < ntile; t += gridDim.x) {
    const int kt = t % kts, nt = t / kts;
#pragma unroll
    for (int ps = 0; ps < 4; ++ps) {
      float* tp = tile + (r0 + 16 * ps) * 65 + c4 * 4;
      tp[0] = v[ps].x; tp[1] = v[ps].y; tp[2] = v[ps].z; tp[3] = v[ps].w;
    }
    if (t + (int)gridDim.x < ntile) load(t + gridDim.x);
    __syncthreads();
#pragma unroll
    for (int ps = 0; ps < 2; ++ps) {
      const int nr = (tid >> 3) + 32 * ps, kc = tid & 7;
      const int n = nt * 64 + nr;
      if (n < N) {
        const float* tp = tile + (kc * 8) * 65 + nr;
        uint4 o;
        o.x = pack2(tp[0 * 65], tp[1 * 65]); o.y = pack2(tp[2 * 65], tp[3 * 65]);
        o.z = pack2(tp[4 * 65], tp[5 * 65]); o.w = pack2(tp[6 * 65], tp[7 * 65]);
        *(uint4*)(dst + (size_t)n * K + kt * 64 + kc * 8) = o;
      }
    }
    __syncthreads();
  }
}

DI void phase_prep(const Params& p, char* smem) {
  const int tid = threadIdx.x, lane = tid & 63, wave = tid >> 6;
  const int gw = blockIdx.x * 4 + wave, nw = gridDim.x * 4;
  bf16_t* U = (bf16_t*)((char*)p.out + OUT_U);
  {
    float4 v[4], nx[4];
    int r = gw;
    if (r < MROWS) {
      const float* src = r < MSEQ ? p.x + (size_t)r * DM : p.meta + (size_t)(r - MSEQ) * DM;
#pragma unroll
      for (int q = 0; q < 4; ++q) { const f32x4 t_ = __builtin_nontemporal_load((const f32x4*)src + q * 64 + lane); v[q] = make_float4(t_[0], t_[1], t_[2], t_[3]); }
    }
    float4 g[4];
#pragma unroll
    for (int q = 0; q < 4; ++q) g[q] = ((const float4*)p.norm_g)[q * 64 + lane];
    for (; r < MROWS; r += nw) {
      const int rn = r + nw;
      if (rn < MROWS) {
        const float* src = rn < MSEQ ? p.x + (size_t)rn * DM : p.meta + (size_t)(rn - MSEQ) * DM;
#pragma unroll
        for (int q = 0; q < 4; ++q) { const f32x4 t_ = __builtin_nontemporal_load((const f32x4*)src + q * 64 + lane); nx[q] = make_float4(t_[0], t_[1], t_[2], t_[3]); }
      }
      float ss = 0.f;
#pragma unroll
      for (int q = 0; q < 4; ++q) ss += v[q].x * v[q].x + v[q].y * v[q].y + v[q].z * v[q].z + v[q].w * v[q].w;
      ss = wave_sum(ss);
      const float rstd = rsqrtf(ss * (1.f / DM) + EPS);
#pragma unroll
      for (int q = 0; q < 4; ++q) {
        uint2 o; o.x = pack2(v[q].x * rstd * g[q].x, v[q].y * rstd * g[q].y); o.y = pack2(v[q].z * rstd * g[q].z, v[q].w * rstd * g[q].w);
        *(uint2*)(U + (size_t)r * DM + (q * 64 + lane) * 4) = o;
      }
#pragma unroll
      for (int q = 0; q < 4; ++q) v[q] = nx[q];
    }
  }
  transpose_to_bf16(p.w_in, (bf16_t*)((char*)p.out + OUT_WINT), DM, NIN, (float*)smem);
  transpose_to_bf16(p.w_out, (bf16_t*)(p.ws + OFF_WOT), 2048, DM, (float*)smem);
  const int gt = blockIdx.x * 256 + tid, nt = gridDim.x * 256;
  float* ct = (float*)(p.ws + OFF_COS); float* st = (float*)(p.ws + OFF_SIN);
  for (int i = gt; i < LTOK * 64; i += nt) {
    const int l = i >> 6, j = i & 63;
    const float inv = (float)exp(-(double)j * (1.0 / 64.0) * 9.210340371976184);
    const float ang = (float)l * inv;
    double t = (double)ang * 0.15915494309189535; t -= rint(t);
    ct[i] = __builtin_amdgcn_cosf((float)t); st[i] = __builtin_amdgcn_sinf((float)t);
  }
}

DI float log_sigmoid(float v) { return v >= 0.f ? -log1pf(expf(-v)) : v - log1pf(expf(v)); }

DI void thin_tasks(const Params& p) {
  const int tid = threadIdx.x, lane = tid & 63, wave = tid >> 6;
  const int gw = blockIdx.x * 4 + wave, nw = gridDim.x * 4;
  const bf16_t* U = (const bf16_t*)((const char*)p.out + OUT_U);
  const bf16_t* WT = (const bf16_t*)((const char*)p.out + OUT_WINT);
  const int l16 = lane & 15, q4 = lane >> 4;
  for (int task = gw; task < 1025 + 112; task += nw) {
    if (task < 1025) {
      const int r0 = task * 16;
      const bf16_t* ap = U + (size_t)(r0 + l16) * DM + q4 * 8;
      const bf16_t* bp = WT + (size_t)(NMAIN + l16) * DM + q4 * 8;
      f32x4 acc = {0.f, 0.f, 0.f, 0.f};
#pragma unroll 8
      for (int ks = 0; ks < 32; ++ks) {
        const bf16x8 a = *(const bf16x8*)(ap + ks * 32), b = *(const bf16x8*)(bp + ks * 32);
        acc = MFMA16(a, b, acc);
      }
      const float bias = p.b_f[l16];
      float4 o;
      o.x = log_sigmoid(acc[0] + bias) * LOG2E; o.y = log_sigmoid(acc[1] + bias) * LOG2E;
      o.z = log_sigmoid(acc[2] + bias) * LOG2E; o.w = log_sigmoid(acc[3] + bias) * LOG2E;
      if (task < 1024) {
        const int b = r0 >> 11, s = (r0 & 2047) + q4 * 4;
        *(float4*)((float*)(p.ws + OFF_LF) + (size_t)(b * 16 + l16) * 2048 + s) = o;
      } else {
        *(float4*)((float*)(p.ws + OFF_LFM) + l16 * 16 + q4 * 4) = o;
      }
    } else {
      const int mtk = task - 1025, tl = mtk >> 2, pr = mtk & 3;
      const int nt = tl < 4 ? 4 + tl : tl < 12 ? 8 + (tl - 4) : tl < 20 ? 32 + (tl - 12) : 40 + (tl - 20);
      const int jA = 16 * pr + l16;
      const bf16_t* ap = U + (size_t)(MSEQ + l16) * DM + q4 * 8;
      const bf16_t* bp0 = WT + (size_t)(nt * 128 + jA) * DM + q4 * 8;
      const bf16_t* bp1 = bp0 + (size_t)64 * DM;
      f32x4 a0 = {0.f, 0.f, 0.f, 0.f}, a1 = {0.f, 0.f, 0.f, 0.f};
#pragma unroll 4
      for (int ks = 0; ks < 32; ++ks) {
        const bf16x8 a = *(const bf16x8*)(ap + ks * 32);
        const bf16x8 b0 = *(const bf16x8*)(bp0 + ks * 32), b1 = *(const bf16x8*)(bp1 + ks * 32);
        a0 = MFMA16(a, b0, a0); a1 = MFMA16(a, b1, a1);
      }
      const int m0 = q4 * 4;
      if (nt < 8) {
        const int h = nt - 4; const float lg = lg2gamma(h);
        bf16_t* RK = (bf16_t*)(p.ws + OFF_RK);
        const float* ct = (const float*)(p.ws + OFF_COS); const float* sn = (const float*)(p.ws + OFF_SIN);
#pragma unroll
        for (int i = 0; i < 4; ++i) {
          const int m = m0 + i;
          const float c = ct[m * 64 + jA], s = sn[m * 64 + jA];
          const float sc = DKS * exp2f(-(float)(m - PCENTER) * lg);
          bf16_t* d = RK + (size_t)(MSEQ + m) * 512 + h * 128 + jA;
          d[0] = f2bf((a0[i] * c - a1[i] * s) * sc); d[64] = f2bf((a0[i] * s + a1[i] * c) * sc);
        }
      } else if (nt < 16) {
        const int c0 = (nt - 8) * 128 + jA, c1 = c0 + 64;
        bf16_t* V = (bf16_t*)(p.ws + OFF_RVTM);
        uint2 o; o.x = pack2(a0[0], a0[1]); o.y = pack2(a0[2], a0[3]);
        *(uint2*)(V + (size_t)c0 * 16 + m0) = o;
        o.x = pack2(a1[0], a1[1]); o.y = pack2(a1[2], a1[3]);
        *(uint2*)(V + (size_t)c1 * 16 + m0) = o;
      } else if (nt < 40) {
        bf16_t* FK = (bf16_t*)(p.ws + OFF_FK);
        const int c0 = (nt - 32) * 128 + jA;
#pragma unroll
        for (int i = 0; i < 4; ++i) { bf16_t* d = FK + (size_t)(MSEQ + m0 + i) * 1024 + c0; d[0] = f2bf(a0[i]); d[64] = f2bf(a1[i]); }
      } else {
        const int c0 = (nt - 40) * 128 + jA, c1 = c0 + 64;
        bf16_t* V = (bf16_t*)(p.ws + OFF_FVTM);
        uint2 o; o.x = pack2(a0[0], a0[1]); o.y = pack2(a0[2], a0[3]);
        *(uint2*)(V + (size_t)c0 * 16 + m0) = o;
        o.x = pack2(a1[0], a1[1]); o.y = pack2(a1[2], a1[3]);
        *(uint2*)(V + (size_t)c1 * 16 + m0) = o;
      }
    }
  }
}

constexpr int GS = 64;
constexpr int GA = 256 * GS, GB = 128 * GS;
constexpr int GSTAGE = GA + GB;

template <bool OUTP>
DI void gemm_phase(const Params& p, char* smem) {
  constexpr int KT = OUTP ? 64 : 32;
  constexpr int SNT = OUTP ? 1 : 7;
  constexpr int NSUP = 8 * SNT;
  constexpr int SPX = NSUP / 8;
  const int xcd = blockIdx.x & 7, loc = blockIdx.x >> 3, nloc = gridDim.x >> 3;
  const int tid = threadIdx.x, lane = tid & 63, wave = tid >> 6;
  const int l32 = lane & 31, hl = lane >> 5;
  const int wm = wave >> 1, wn = wave & 1;
  const bf16_t* Ab0; const bf16_t* Ab1; const bf16_t* Bb; int ldb;
  if (OUTP) { Ab0 = (const bf16_t*)(p.ws + OFF_RG); Ab1 = (const bf16_t*)(p.ws + OFF_FG); Bb = (const bf16_t*)(p.ws + OFF_WOT); ldb = 2048; }
  else { Ab0 = Ab1 = (const bf16_t*)((const char*)p.out + OUT_U); Bb = (const bf16_t*)((const char*)p.out + OUT_WINT); ldb = 1024; }
  float* ssl = (float*)(smem + 3 * GSTAGE);

  unsigned aoff[4], boff[2];
  auto set_tile = [&](int i) {
    const int s = xcd * SPX + (i >> 6), in = i & 63;
    const int mt_ = (s / SNT) * 8 + (in >> 3), nt_ = (s % SNT) * 8 + (in & 7);
    const int r16 = lane >> 2, pc = lane & 3;
#pragma unroll
    for (int j = 0; j < 4; ++j) { const int row = (wave * 4 + j) * 16 + r16; aoff[j] = (unsigned)(((mt_ * 256 + row) * 1024 + (pc ^ ((row >> 2) & 3)) * 8) * 2); }
#pragma unroll
    for (int j = 0; j < 2; ++j) { const int row = (wave * 2 + j) * 16 + r16; boff[j] = (unsigned)(((nt_ * 128 + row) * ldb + (pc ^ ((row >> 2) & 3)) * 8) * 2); }
  };
  auto dma = [&](int kt, int stg) {
    const int k0 = kt * 32;
    const char* Ak = (const char*)(OUTP ? (k0 < 1024 ? Ab0 : Ab1) : Ab0) + (OUTP ? (k0 & 1023) : k0) * 2;
    const char* Bk = (const char*)Bb + k0 * 2;
    char* As = smem + stg * GSTAGE + wave * 4096 + lane * 16; char* Bs = smem + stg * GSTAGE + GA + wave * 2048 + lane * 16;
#pragma unroll
    for (int j = 0; j < 4; ++j)
      __builtin_amdgcn_global_load_lds((const unsigned*)(Ak + aoff[j]), (__attribute__((address_space(3))) unsigned*)(As + j * 1024), 16, 0, 0);
#pragma unroll
    for (int j = 0; j < 2; ++j)
      __builtin_amdgcn_global_load_lds((const unsigned*)(Bk + boff[j]), (__attribute__((address_space(3))) unsigned*)(Bs + j * 1024), 16, 0, 0);
  };
  const int fsw = (l32 >> 2) & 3;
  const int cof0 = ((0 + hl) ^ fsw) * 16, cof1 = ((2 + hl) ^ fsw) * 16;

  __syncthreads();
  int ti = loc;
  if (!OUTP && ti < SPX * 64) { set_tile(ti); dma(0, 0); dma(1, 1); }
#pragma unroll 1
  for (; ti < SPX * 64; ti += nloc) {
  if (OUTP) { set_tile(ti); dma(0, 0); dma(1, 1); }
  const int s_ = xcd * SPX + (ti >> 6), in_ = ti & 63;
  const int mt = (s_ / SNT) * 8 + (in_ >> 3), nt = (s_ % SNT) * 8 + (in_ & 7);
  const int m0 = mt * 256, n0 = nt * 128;
  if (OUTP) ssl[tid] = 0.f;

  f32x16 acc[4][2];
#pragma unroll
  for (int a = 0; a < 4; ++a)
#pragma unroll
    for (int b = 0; b < 2; ++b) acc[a][b] = zero16();

  typedef __attribute__((ext_vector_type(4))) unsigned u32x4_t;
  const unsigned lds_base = (unsigned)(size_t)smem;
  const unsigned a_rd = lds_base + (unsigned)((wm * 128 + l32) * GS), b_rd = lds_base + (unsigned)(GA + (wn * 32 + l32) * GS);
  u32x4_t a0, a1, a2, a3, b0, b1, c0, c1, c2, c3, d0, d1;
  auto issue_reads = [&](int stg) {
    const unsigned so = (unsigned)(stg * GSTAGE);
    const unsigned aa0 = a_rd + so + cof0, bb0 = b_rd + so + cof0, aa1 = a_rd + so + cof1, bb1 = b_rd + so + cof1;
    asm volatile(
        "ds_read_b128 %0, %12\n\t"
        "ds_read_b128 %1, %12 offset:2048\n\t"
        "ds_read_b128 %2, %12 offset:4096\n\t"
        "ds_read_b128 %3, %12 offset:6144\n\t"
        "ds_read_b128 %4, %13\n\t"
        "ds_read_b128 %5, %13 offset:4096\n\t"
        "ds_read_b128 %6, %14\n\t"
        "ds_read_b128 %7, %14 offset:2048\n\t"
        "ds_read_b128 %8, %14 offset:4096\n\t"
        "ds_read_b128 %9, %14 offset:6144\n\t"
        "ds_read_b128 %10, %15\n\t"
        "ds_read_b128 %11, %15 offset:4096"
        : "=&v"(a0), "=&v"(a1), "=&v"(a2), "=&v"(a3), "=&v"(b0), "=&v"(b1), "=&v"(c0), "=&v"(c1), "=&v"(c2), "=&v"(c3), "=&v"(d0), "=&v"(d1)
        : "v"(aa0), "v"(bb0), "v"(aa1), "v"(bb1)
        : "memory");
  };
  auto mfmas = [&]() {
#define BF(x) __builtin_bit_cast(bf16x8, x)
    asm volatile("s_waitcnt lgkmcnt(6)" : "+v"(a0), "+v"(a1), "+v"(a2), "+v"(a3), "+v"(b0), "+v"(b1), "+v"(c0), "+v"(c1), "+v"(c2), "+v"(c3), "+v"(d0), "+v"(d1) :: "memory");
    acc[0][0] = MFMA32(BF(a0), BF(b0), acc[0][0]); acc[0][1] = MFMA32(BF(a0), BF(b1), acc[0][1]);
    acc[1][0] = MFMA32(BF(a1), BF(b0), acc[1][0]); acc[1][1] = MFMA32(BF(a1), BF(b1), acc[1][1]);
    acc[2][0] = MFMA32(BF(a2), BF(b0), acc[2][0]); acc[2][1] = MFMA32(BF(a2), BF(b1), acc[2][1]);
    acc[3][0] = MFMA32(BF(a3), BF(b0), acc[3][0]); acc[3][1] = MFMA32(BF(a3), BF(b1), acc[3][1]);
    asm volatile("s_waitcnt lgkmcnt(0)" : "+v"(c0), "+v"(c1), "+v"(c2), "+v"(c3), "+v"(d0), "+v"(d1) :: "memory");
    acc[0][0] = MFMA32(BF(c0), BF(d0), acc[0][0]); acc[0][1] = MFMA32(BF(c0), BF(d1), acc[0][1]);
    acc[1][0] = MFMA32(BF(c1), BF(d0), acc[1][0]); acc[1][1] = MFMA32(BF(c1), BF(d1), acc[1][1]);
    acc[2][0] = MFMA32(BF(c2), BF(d0), acc[2][0]); acc[2][1] = MFMA32(BF(c2), BF(d1), acc[2][1]);
    acc[3][0] = MFMA32(BF(c3), BF(d0), acc[3][0]); acc[3][1] = MFMA32(BF(c3), BF(d1), acc[3][1]);
#undef BF
  };
  asm volatile("s_waitcnt vmcnt(0)" ::: "memory");
  __syncthreads();
  int stg = 0;
#pragma unroll 1
  for (int kt = 0; kt < KT; ++kt) {
    const bool more = kt + 2 < KT;
    issue_reads(stg);
    if (more) dma(kt + 2, stg == 0 ? 2 : stg - 1);
    mfmas();
    if (more) asm volatile("s_waitcnt vmcnt(6)" ::: "memory");
    else asm volatile("s_waitcnt vmcnt(0)" ::: "memory");
    __builtin_amdgcn_s_barrier();
    stg = stg == 2 ? 0 : stg + 1;
  }
  if (!OUTP && ti + nloc < SPX * 64) { set_tile(ti + nloc); dma(0, 0); dma(1, 1); }

  const int cl = wn * 32 + l32;
  if (OUTP) {
    const char* xb = (const char*)p.x; char* ob = (char*)p.out;
    const int rl0 = wm * 128 + 4 * hl;
    const unsigned off0 = (unsigned)(((m0 + rl0) * DM + n0 + cl) * 4);
#pragma unroll
    for (int mi = 0; mi < 4; ++mi)
#pragma unroll
      for (int i = 0; i < 16; ++i) {
        const int dr = mi * 32 + 8 * (i >> 2) + (i & 3);
        const unsigned off = off0 + (unsigned)(dr * DM * 4);
        const float h0 = __builtin_nontemporal_load((const float*)(xb + off)) + acc[mi][0][i], h1 = __builtin_nontemporal_load((const float*)(xb + off + 256)) + acc[mi][1][i];
        acc[mi][0][i] = h0; acc[mi][1][i] = h1;
        atomicAdd(&ssl[rl0 + dr], h0 * h0 + h1 * h1);
        if ((i & 7) == 7) asm volatile("" ::: "memory");
      }
    __syncthreads();
    float* exch = (float*)(p.ws + OFF_EXCH) + (size_t)mt * 8 * 256;
    unsigned* flag = (unsigned*)(p.ws + OFF_CTR) + 64 + mt;
    __hip_atomic_store(exch + nt * 256 + tid, ssl[tid], __ATOMIC_RELAXED, __HIP_MEMORY_SCOPE_AGENT);
    asm volatile("s_waitcnt vmcnt(0)" ::: "memory");
    __syncthreads();
    if (tid == 0) {
      __hip_atomic_fetch_add(flag, 1u, __ATOMIC_RELAXED, __HIP_MEMORY_SCOPE_AGENT);
      while (__hip_atomic_load(flag, __ATOMIC_RELAXED, __HIP_MEMORY_SCOPE_AGENT) < 8u) __builtin_amdgcn_s_sleep(1);
    }
    __syncthreads();
    {
      float tot = 0.f;
#pragma unroll
      for (int c = 0; c < 8; ++c) tot += __hip_atomic_load(exch + c * 256 + tid, __ATOMIC_RELAXED, __HIP_MEMORY_SCOPE_AGENT);
      ssl[tid] = rsqrtf(tot * (1.f / DM) + EPS);
    }
    __syncthreads();
    const float g0 = p.final_g[n0 + cl], g1 = p.final_g[n0 + cl + 64];
#pragma unroll
    for (int mi = 0; mi < 4; ++mi)
#pragma unroll
      for (int i = 0; i < 16; ++i) {
        const int dr = mi * 32 + 8 * (i >> 2) + (i & 3);
        const unsigned off = off0 + (unsigned)(dr * DM * 4);
        const float rs = ssl[rl0 + dr];
        __builtin_nontemporal_store(acc[mi][0][i] * rs * g0, (float*)(ob + off)); __builtin_nontemporal_store(acc[mi][1][i] * rs * g1, (float*)(ob + off + 256));
      }
    __syncthreads();
  } else {
    if (nt < 8) {
      const int h = nt & 3; const float lg = lg2gamma(h);
      const bool isq = nt < 4;
      char* dbase = isq ? (char*)(p.ws + OFF_RQ) : (char*)(p.ws + OFF_RK);
      const float* ct = (const float*)(p.ws + OFF_COS); const float* sn = (const float*)(p.ws + OFF_SIN);
      const int rb = m0 + wm * 128 + 4 * hl;
      const unsigned off0 = (unsigned)((rb * 512 + h * 128 + cl) * 2);
      const float sgn = isq ? lg : -lg, mul = isq ? 1.f : DKS;
#pragma unroll
      for (int mi = 0; mi < 4; ++mi)
#pragma unroll
        for (int i = 0; i < 16; ++i) {
          const int dr = mi * 32 + 8 * (i >> 2) + (i & 3);
          const int pos = NMETA + ((rb + dr) & 2047);
          const float c = ct[pos * 64 + cl], s = sn[pos * 64 + cl];
          const float sc = mul * __builtin_amdgcn_exp2f((float)(pos - PCENTER) * sgn);
          const float x1 = acc[mi][0][i], x2 = acc[mi][1][i];
          const unsigned u = pack2((x1 * c - x2 * s) * sc, (x1 * s + x2 * c) * sc);
          char* d = dbase + (off0 + (unsigned)(dr * 1024));
          *(bf16_t*)d = (bf16_t)u; *(bf16_t*)(d + 128) = (bf16_t)(u >> 16);
          if ((i & 7) == 7) asm volatile("" ::: "memory");
        }
    } else if ((nt >= 8 && nt < 16) || (nt >= 40 && nt < 48)) {
      const bool isr = nt < 16;
      bf16_t* V = isr ? (bf16_t*)(p.ws + OFF_RVT) : (bf16_t*)(p.ws + OFF_FVT);
      const int b = m0 >> 11;
#pragma unroll
      for (int ni = 0; ni < 2; ++ni) {
        const int c = (isr ? (nt - 8) : (nt - 40)) * 128 + cl + 64 * ni;
        bf16_t* vrow = V + ((size_t)b * 1024 + c) * 2048 + (m0 & 2047);
#pragma unroll
        for (int mi = 0; mi < 4; ++mi) {
          uint2 o[4];
#pragma unroll
          for (int g = 0; g < 4; ++g) { o[g].x = pack2(acc[mi][ni][4 * g], acc[mi][ni][4 * g + 1]); o[g].y = pack2(acc[mi][ni][4 * g + 2], acc[mi][ni][4 * g + 3]); }
#pragma unroll
          for (int k = 0; k < 4; k += 2) {
            auto r0 = __builtin_amdgcn_permlane32_swap(o[k].x, o[k + 1].x, false, false);
            auto r1 = __builtin_amdgcn_permlane32_swap(o[k].y, o[k + 1].y, false, false);
            *(uint4*)(vrow + wm * 128 + mi * 32 + 8 * k + 8 * hl) = make_uint4(r0[0], r1[0], r0[1], r1[1]);
          }
        }
      }
    } else {
      char* dbase; int cb; int mode;
      if (nt < 24) { dbase = (char*)(p.ws + OFF_RG); cb = (nt - 16) * 128; mode = 0; }
      else if (nt < 32) { dbase = (char*)(p.ws + OFF_FQ); cb = (nt - 24) * 128; mode = 1; }
      else if (nt < 40) { dbase = (char*)(p.ws + OFF_FK); cb = (nt - 32) * 128; mode = 2; }
      else { dbase = (char*)(p.ws + OFF_FG); cb = (nt - 48) * 128; mode = 0; }
      const unsigned off0 = (unsigned)(((m0 + wm * 128 + 4 * hl) * 1024 + cb + cl) * 2);
#define ROWMAJOR_STORE(EXPR0, EXPR1) \
      _Pragma("unroll") for (int mi = 0; mi < 4; ++mi) \
      _Pragma("unroll") for (int i = 0; i < 16; ++i) { \
        const float a0 = acc[mi][0][i], a1 = acc[mi][1][i]; \
        const unsigned u = pack2(EXPR0, EXPR1); \
        char* d = dbase + (off0 + (unsigned)((mi * 32 + 8 * (i >> 2) + (i & 3)) * 2048)); \
        *(bf16_t*)d = (bf16_t)u; *(bf16_t*)(d + 128) = (bf16_t)(u >> 16); \
      }
      if (mode == 0) { ROWMAJOR_STORE(silu(a0), silu(a1)) }
      else if (mode == 1) { ROWMAJOR_STORE(a0 * QSCALE, a1 * QSCALE) }
      else { ROWMAJOR_STORE(a0, a1) }
#undef ROWMAJOR_STORE
    }
  }
  }
}

DI int kperm(int m) { return 16 * (m >> 4) + 8 * ((m >> 2) & 1) + 4 * ((m >> 3) & 1) + (m & 3); }

template <bool FOX>
struct MixCfg {
  static constexpr int DK = FOX ? 64 : 128, DV = FOX ? 64 : 256, NH = FOX ? 16 : 4;
  static constexpr int TK = FOX ? 64 : 32;
  static constexpr int KSTR = (DK + 8) * 2, VSTR = TK * 2 + 16;
  static constexpr int NKS = DK / 16, NMB = FOX ? 2 : 4, KCH = DK / 8, VCH = TK / 8, NKB = TK / 32;
  static constexpr int QLD = FOX ? 1024 : 512;
  static constexpr int QPB = FOX ? 128 : 64;
  static constexpr int NKL = TK * KCH / 256, NVL = DV * VCH / 256;
  static constexpr int STAGE = TK * KSTR + DV * VSTR;
  static constexpr int PADK = TK - 16;
};

template <bool FOX>
DI void mixer_sub(const Params& p, char* smem, int b, int h, int qi) {
  typedef MixCfg<FOX> C;
  constexpr int DK = C::DK, DV = C::DV, NH = C::NH, TK = C::TK, KSTR = C::KSTR, VSTR = C::VSTR, NKS = C::NKS, NMB = C::NMB;
  constexpr int KCH = C::KCH, VCH = C::VCH, NKB = C::NKB, QLD = C::QLD, QPB = C::QPB, PADK = C::PADK;
  float* c2 = (float*)(smem + 2 * C::STAGE);
  const int tid = threadIdx.x, lane = tid & 63, wave = tid >> 6, l32 = lane & 31, hl = lane >> 5;
  const int qg = FOX ? wave : (wave & 1), dh = FOX ? 0 : (wave >> 1);
  const bf16_t* Qg = FOX ? (const bf16_t*)(p.ws + OFF_FQ) : (const bf16_t*)(p.ws + OFF_RQ);
  const bf16_t* Kg = FOX ? (const bf16_t*)(p.ws + OFF_FK) : (const bf16_t*)(p.ws + OFF_RK);
  const bf16_t* Vg = FOX ? (const bf16_t*)(p.ws + OFF_FVT) : (const bf16_t*)(p.ws + OFF_RVT);
  const bf16_t* Vm = FOX ? (const bf16_t*)(p.ws + OFF_FVTM) : (const bf16_t*)(p.ws + OFF_RVTM);
  bf16_t* Gg = FOX ? (bf16_t*)(p.ws + OFF_FG) : (bf16_t*)(p.ws + OFF_RG);

  const int eq0 = TK + qi * QPB + qg * 32;

  const int qrow = b * 2048 + qi * QPB + qg * 32 + l32;
  bf16x8 qf[NKS];
  {
    const bf16_t* qp = Qg + (size_t)qrow * QLD + h * DK + hl * 8;
#pragma unroll
    for (int ks = 0; ks < NKS; ++ks) qf[ks] = *(const bf16x8*)(qp + ks * 16);
  }
  bf16_t* gp = Gg + (size_t)qrow * 1024 + h * DV + dh * 128 + 8 * hl;
  uint4 gpre[NMB * 2];
  if (FOX) {
#pragma unroll
    for (int mb = 0; mb < NMB; ++mb)
#pragma unroll
      for (int k = 0; k < 2; ++k) gpre[mb * 2 + k] = *(const uint4*)(gp + mb * 32 + 16 * k);
  }
  f32x16 O[NMB];
#pragma unroll
  for (int mb = 0; mb < NMB; ++mb) O[mb] = zero16();
  float mrun = -BIG, lrun = 0.f;

  const int NT = 1 + QPB * (qi + 1) / TK;
  const int prow = kperm(l32);
  constexpr int NSET = FOX ? 2 : 1;
  uint4 pk[NSET][C::NKL], pv[NSET][C::NVL];
  typedef std::integral_constant<int, 0> I0; typedef std::integral_constant<int, 1> I1;
  const unsigned char* wsb = p.ws;
  constexpr unsigned KOFF = (unsigned)(FOX ? OFF_FK : OFF_RK), VOFF = (unsigned)(FOX ? OFF_FVT : OFF_RVT), VMOFF = (unsigned)(FOX ? OFF_FVTM : OFF_RVTM);
  constexpr unsigned KDELTA = (256 / KCH) * QLD * 2, VDELTA = (256 / VCH) * 2048 * 2, VMDELTA = (256 / VCH) * 16 * 2;
  const int key0 = tid / KCH, kc0 = tid % KCH, d0 = tid / VCH, vc0 = tid % VCH;
  const unsigned kb0 = KOFF + (unsigned)(((b * 2048 + key0) * QLD + h * DK + kc0 * 8) * 2);
  const unsigned km0 = KOFF + (unsigned)(((MSEQ + key0 - PADK) * QLD + h * DK + kc0 * 8) * 2);
  const unsigned vb0 = VOFF + (unsigned)((((b * NH + h) * DV + d0) * 2048 + vc0 * 8) * 2);
  const unsigned vm0 = VMOFF + (unsigned)(((h * DV + d0) * 16 + (vc0 - PADK / 8) * 8) * 2);
  auto issue = [&](int jt, auto sc) {
    constexpr int S = decltype(sc)::value;
    if (jt == 0) {
#pragma unroll
      for (int ps = 0; ps < C::NKL; ++ps) {
        uint4 v = make_uint4(0u, 0u, 0u, 0u);
        if (key0 + ps * (256 / KCH) >= PADK) v = *(const uint4*)(wsb + (km0 + ps * KDELTA));
        pk[S][ps] = v;
      }
#pragma unroll
      for (int ps = 0; ps < C::NVL; ++ps) {
        uint4 v = make_uint4(0u, 0u, 0u, 0u);
        if (vc0 >= PADK / 8) v = *(const uint4*)(wsb + (vm0 + ps * VMDELTA));
        pv[S][ps] = v;
      }
    } else {
      const unsigned kt = kb0 + (unsigned)(jt - 1) * (TK * QLD * 2), vt = vb0 + (unsigned)(jt - 1) * (TK * 2);
#pragma unroll
      for (int ps = 0; ps < C::NKL; ++ps) pk[S][ps] = *(const uint4*)(wsb + (kt + ps * KDELTA));
#pragma unroll
      for (int ps = 0; ps < C::NVL; ++ps) pv[S][ps] = *(const uint4*)(wsb + (vt + ps * VDELTA));
    }
  };
  auto commit = [&](auto bc, auto sc) {
    constexpr int S = decltype(sc)::value;
    char* Ks = smem + decltype(bc)::value * C::STAGE; char* Vs = Ks + TK * KSTR;
#pragma unroll
    for (int ps = 0; ps < C::NKL; ++ps) { const int q = tid + 256 * ps, key = q / KCH, kc = q % KCH; *(uint4*)(Ks + key * KSTR + kc * 16) = pk[S][ps]; }
#pragma unroll
    for (int ps = 0; ps < C::NVL; ++ps) { const int q = tid + 256 * ps, d = q / VCH, kc = q % VCH; *(uint4*)(Vs + d * VSTR + kc * 16) = pv[S][ps]; }
  };
  if (NSET == 2) {
    issue(NT - 1, I0{}); if (NT > 1) issue(NT - 2, std::integral_constant<int, NSET - 1>{});
    commit(I0{}, I0{});
    if (NT > 2) issue(NT - 3, I0{});
  } else {
    issue(NT - 1, I0{}); commit(I0{}, I0{});
    if (NT > 1) issue(NT - 2, I0{});
  }
  __syncthreads();
  auto step = [&](int t, auto sc) {
    constexpr int S = decltype(sc)::value;
    typedef std::integral_constant<int, 1 - S> IN;
    const int jt = NT - 1 - t;
    const char* Ks = smem + S * C::STAGE; const char* Vs = Ks + TK * KSTR;
    const int ek0 = TK * jt;
    if (ek0 <= eq0 + 31) {
      const bool need_mask = (ek0 + TK - 1 > eq0);
      const int eq = eq0 + l32;
      if (FOX) {
        f32x16 st[2];
#pragma unroll
        for (int kb = 0; kb < 2; ++kb) {
#pragma unroll
          for (int s = 0; s < 2; ++s) {
            const float* cp = c2 + ek0 + 32 * kb + 16 * s + 8 * hl;
            const f32x4 ca = *(const f32x4*)cp, cb = *(const f32x4*)(cp + 4);
#pragma unroll
            for (int j = 0; j < 4; ++j) { st[kb][8 * s + j] = ca[j]; st[kb][8 * s + 4 + j] = cb[j]; }
          }
          const char* kp = Ks + (kb * 32 + prow) * KSTR + hl * 16;
#pragma unroll
          for (int ks = 0; ks < NKS; ++ks) { const bf16x8 a = *(const bf16x8*)(kp + ks * 32); st[kb] = MFMA32(a, qf[ks], st[kb]); }
        }
        if (need_mask) {
#pragma unroll
          for (int kb = 0; kb < 2; ++kb)
#pragma unroll
            for (int i = 0; i < 16; ++i) { const int ek = ek0 + 32 * kb + 16 * (i >> 3) + 8 * hl + (i & 7); if (ek > eq) st[kb][i] = -BIG; }
        }
        float mx = -BIG;
#pragma unroll
        for (int kb = 0; kb < 2; ++kb)
#pragma unroll
          for (int i = 0; i < 16; i += 2) mx = fmaxf(fmaxf(mx, st[kb][i]), st[kb][i + 1]);
        mx = xhalf_max(mx);
        const float mnew = fmaxf(mrun, mx);
        if (__any(mnew != mrun)) {
          const float alpha = __builtin_amdgcn_exp2f(mrun - mnew);
          mrun = mnew;
          lrun *= alpha;
#pragma unroll
          for (int mb = 0; mb < NMB; ++mb)
#pragma unroll
            for (int i = 0; i < 16; ++i) O[mb][i] *= alpha;
        }
        f32x2 ps2 = {0.f, 0.f};
        const f32x2 m2 = {mnew, mnew};
#pragma unroll
        for (int kb = 0; kb < 2; ++kb)
#pragma unroll
          for (int i = 0; i < 16; i += 2) {
            f32x2 t = {st[kb][i], st[kb][i + 1]};
            t = t - m2;
            t[0] = __builtin_amdgcn_exp2f(t[0]); t[1] = __builtin_amdgcn_exp2f(t[1]);
            ps2 = ps2 + t;
            st[kb][i] = t[0]; st[kb][i + 1] = t[1];
          }
        lrun += ps2[0] + ps2[1];
        bf16x8 pf[2][2];
#pragma unroll
        for (int kb = 0; kb < 2; ++kb)
#pragma unroll
          for (int s = 0; s < 2; ++s) {
            uint4 u;
            u.x = pack2(st[kb][8 * s + 0], st[kb][8 * s + 1]); u.y = pack2(st[kb][8 * s + 2], st[kb][8 * s + 3]);
            u.z = pack2(st[kb][8 * s + 4], st[kb][8 * s + 5]); u.w = pack2(st[kb][8 * s + 6], st[kb][8 * s + 7]);
            pf[kb][s] = __builtin_bit_cast(bf16x8, u);
          }
#pragma unroll
        for (int mb = 0; mb < NMB; ++mb) {
          const char* vp = Vs + (mb * 32 + l32) * VSTR + hl * 16;
#pragma unroll
          for (int kb = 0; kb < 2; ++kb)
#pragma unroll
            for (int s = 0; s < 2; ++s) { const bf16x8 a = *(const bf16x8*)(vp + kb * 64 + s * 32); O[mb] = MFMA32(a, pf[kb][s], O[mb]); }
        }
      } else {
        f32x16 st = zero16(), st1 = zero16();
        const char* kp = Ks + prow * KSTR + hl * 16;
#pragma unroll
        for (int ks = 0; ks < NKS; ks += 2) {
          const bf16x8 a = *(const bf16x8*)(kp + ks * 32), a1 = *(const bf16x8*)(kp + (ks + 1) * 32);
          st = MFMA32(a, qf[ks], st); st1 = MFMA32(a1, qf[ks + 1], st1);
        }
#pragma unroll
        for (int i = 0; i < 16; ++i) st[i] += st1[i];
        if (need_mask) {
#pragma unroll
          for (int i = 0; i < 16; ++i) { const int ek = ek0 + 16 * (i >> 3) + 8 * hl + (i & 7); if (ek > eq) st[i] = 0.f; }
        }
        bf16x8 pf[2];
#pragma unroll
        for (int s = 0; s < 2; ++s) {
          uint4 u;
          u.x = pack2(st[8 * s + 0], st[8 * s + 1]); u.y = pack2(st[8 * s + 2], st[8 * s + 3]);
          u.z = pack2(st[8 * s + 4], st[8 * s + 5]); u.w = pack2(st[8 * s + 6], st[8 * s + 7]);
          pf[s] = __builtin_bit_cast(bf16x8, u);
        }
#pragma unroll
        for (int mb = 0; mb < NMB; ++mb) {
          const char* vp = Vs + (dh * 128 + mb * 32 + l32) * VSTR + hl * 16;
#pragma unroll
          for (int s = 0; s < 2; ++s) { const bf16x8 a = *(const bf16x8*)(vp + s * 32); O[mb] = MFMA32(a, pf[s], O[mb]); }
        }
      }
    }
    if (t + 1 < NT) {
      typedef std::integral_constant<int, NSET == 2 ? 1 - S : 0> RS;
      commit(IN{}, RS{}); if (t + 1 + NSET < NT) issue(jt - 1 - NSET, RS{});
    }
    __syncthreads();
  };
  for (int t = 0; t < NT; t += 2) {
    step(t, I0{});
    if (t + 1 < NT) step(t + 1, I1{});
  }

  if (!FOX) {
#pragma unroll
    for (int mb = 0; mb < NMB; ++mb)
#pragma unroll
      for (int k = 0; k < 2; ++k) gpre[mb * 2 + k] = *(const uint4*)(gp + mb * 32 + 16 * k);
  }
  float scale;
  if (FOX) {
    const float lt = xhalf_sum(lrun);
    scale = 1.f / lt;
  } else {
    float ss = 0.f;
#pragma unroll
    for (int mb = 0; mb < NMB; ++mb)
#pragma unroll
      for (int i = 0; i < 16; ++i) ss += O[mb][i] * O[mb][i];
    ss = xhalf_sum(ss);
    if (hl == 0) c2[wave * 32 + l32] = ss;
    __syncthreads();
    ss += c2[(wave ^ 2) * 32 + l32];
    __syncthreads();
    scale = rsqrtf(ss * (1.f / DV) + EPS);
  }
#pragma unroll
  for (int mb = 0; mb < NMB; ++mb)
#pragma unroll
    for (int k = 0; k < 4; k += 2) {
      uint4* a = (uint4*)(gp + mb * 32 + 8 * k);
      const uint4 L = gpre[mb * 2 + (k >> 1)];
      auto g0 = __builtin_amdgcn_permlane32_swap(L.x, L.z, false, false);
      auto g1 = __builtin_amdgcn_permlane32_swap(L.y, L.w, false, false);
      uint2 o0, o1;
      o0.x = pack2(O[mb][4 * k] * scale * bflo(g0[0]), O[mb][4 * k + 1] * scale * bfhi(g0[0]));
      o0.y = pack2(O[mb][4 * k + 2] * scale * bflo(g1[0]), O[mb][4 * k + 3] * scale * bfhi(g1[0]));
      o1.x = pack2(O[mb][4 * k + 4] * scale * bflo(g0[1]), O[mb][4 * k + 5] * scale * bfhi(g0[1]));
      o1.y = pack2(O[mb][4 * k + 6] * scale * bflo(g1[1]), O[mb][4 * k + 7] * scale * bfhi(g1[1]));
      auto r0 = __builtin_amdgcn_permlane32_swap(o0.x, o1.x, false, false);
      auto r1 = __builtin_amdgcn_permlane32_swap(o0.y, o1.y, false, false);
      *a = make_uint4(r0[0], r1[0], r0[1], r1[1]);
    }
}

template <bool FOX>
DI void mixer_pair(const Params& p, char* smem, int b, int h, int qa) {
  typedef MixCfg<FOX> C;
  const int tid = threadIdx.x, lane = tid & 63, wave = tid >> 6;
  float* c2 = (float*)(smem + 2 * C::STAGE);
  float* tot = c2 + 2112; float* pre = tot + 64;
  __syncthreads();
  if (FOX) {
    const int n_e = 64 + 128 * (qa + 1);
    const float* LF = (const float*)(p.ws + OFF_LF) + (size_t)(b * 16 + h) * 2048;
    const float* LFM = (const float*)(p.ws + OFF_LFM) + h * 16;
    {
      float raw[9];
#pragma unroll
      for (int k = 0; k < 9; ++k) { const int e = tid + 256 * k; raw[k] = (e >= 48 && e < n_e) ? (e < 64 ? LFM[e - 48] : LF[e - 64]) : 0.f; }
#pragma unroll
      for (int k = 0; k < 9; ++k) { const int e = tid + 256 * k; if (e < n_e) c2[e] = raw[k]; }
    }
    __syncthreads();
    for (int ch = wave; ch * 64 < n_e; ch += 4) {
      const int e = ch * 64 + lane;
      float v = c2[e];
#pragma unroll
      for (int o = 1; o < 64; o <<= 1) { const float t = __shfl_up(v, o); if (lane >= o) v += t; }
      c2[e] = v;
      if (lane == 63) tot[ch] = v;
    }
    __syncthreads();
    if (wave == 0) {
      const int nch = n_e >> 6;
      const float t0 = lane < nch ? tot[lane] : 0.f;
      float v = t0;
#pragma unroll
      for (int o = 1; o < 64; o <<= 1) { const float t = __shfl_up(v, o); if (lane >= o) v += t; }
      pre[lane] = v - t0;
    }
    __syncthreads();
    for (int e = tid; e < n_e; e += 256) c2[e] = e < 48 ? -BIG : -(c2[e] + pre[e >> 6]);
    __syncthreads();
  }
  constexpr int NQ = FOX ? 16 : 32;
  const int flip = blockIdx.x >= (gridDim.x >> 1) ? 1 : 0;
#pragma unroll 1
  for (int s = 0; s < 2; ++s) mixer_sub<FOX>(p, smem, b, h, (s ^ flip) ? NQ - 1 - qa : qa);
}

DI void phase_mixers(const Params& p, char* smem) {
  const int xcd = blockIdx.x & 7, loc = blockIdx.x >> 3, nloc = gridDim.x >> 3;
  for (int i = loc; i < 64; i += nloc) mixer_pair<false>(p, smem, xcd, i >> 4, 31 - (i & 15));
  for (int i = loc; i < 128; i += nloc) mixer_pair<true>(p, smem, xcd, i >> 3, 15 - (i & 7));
}

#define XB_TMO      128
#define XB_XCNT(j)  (256  + 64 * (j))
#define XB_XSUB(j)  (1280 + 64 * (j))
#define XB_XGEN(j)  (2304 + 64 * (j))
#define XB_TOP      3328
#define XB_TOPGEN   3392
#define XCD_BAR_WORDS 3456
#define XB_SPIN_CAP (1u << 22)
DI unsigned xb_ld(unsigned* p) { return __hip_atomic_load(p, __ATOMIC_RELAXED, __HIP_MEMORY_SCOPE_AGENT); }
DI unsigned xb_add(unsigned* p, unsigned v) { return __hip_atomic_fetch_add(p, v, __ATOMIC_RELAXED, __HIP_MEMORY_SCOPE_AGENT); }
DI unsigned xb_xcc_id() { return (unsigned)__builtin_amdgcn_s_getreg((3 << 11) | 20) & 0xFu; }
#define XB_SPIN(cond, bar) do { unsigned _sp = 0; while (cond) { __builtin_amdgcn_s_sleep(1); \
    if ((++_sp & 255u) == 0u) { if (xb_ld(&(bar)[XB_TMO])) break; if (_sp > XB_SPIN_CAP) { atomicAdd(&(bar)[XB_TMO], 1u); break; } } } } while (0)
struct XcdBarrier { unsigned* bar; unsigned x; volatile unsigned* st; };
DI XcdBarrier xcd_barrier_post(unsigned* bar, volatile unsigned* st) {
  XcdBarrier b; b.bar = bar; b.x = xb_xcc_id(); b.st = st;
  if (threadIdx.x == 0) (void)xb_add(&bar[XB_XCNT(b.x)], 1u);
  return b;
}
DI void xcd_barrier_complete(unsigned* bar, unsigned x, unsigned& nloc, unsigned& nx) {
  const unsigned G = gridDim.x;
  unsigned sum, cnt, mine, sp = 0u;
  for (;;) {
    sum = 0u; cnt = 0u; mine = 0u;
#pragma unroll
    for (unsigned j = 0; j < 16; ++j) { const unsigned c = xb_ld(&bar[XB_XCNT(j)]); sum += c; cnt += (c > 0u) ? 1u : 0u; mine = (j == x) ? c : mine; }
    if (sum == G) break;
    __builtin_amdgcn_s_sleep(1);
    if ((++sp & 255u) == 0u) { if (xb_ld(&bar[XB_TMO])) break; if (sp > XB_SPIN_CAP) { atomicAdd(&bar[XB_TMO], 1u); break; } }
  }
  nloc = mine > 0u ? mine : 1u; nx = cnt > 0u ? cnt : 1u;
}
DI void xcd_barrier(const XcdBarrier& b) {
  asm volatile("s_waitcnt vmcnt(0)" ::: "memory");
  __syncthreads();
  if (threadIdx.x == 0) {
    unsigned* bar = b.bar;
    __builtin_amdgcn_s_waitcnt(0);
    unsigned nloc = b.st[0], nx = b.st[1];
    if (nloc == 0u) { xcd_barrier_complete(bar, b.x, nloc, nx); b.st[0] = nloc; b.st[1] = nx; }
    const unsigned old = xb_add(&bar[XB_XSUB(b.x)], 1u);
    const unsigned gen = old / nloc;
    if (old + 1u == (gen + 1u) * nloc) {
      __builtin_amdgcn_fence(__ATOMIC_RELEASE, "agent");
      asm volatile("s_waitcnt vmcnt(0)" ::: "memory");
      const unsigned og = xb_add(&bar[XB_TOP], 1u);
      const unsigned tg = og / nx;
      if (og + 1u == (tg + 1u) * nx) xb_add(&bar[XB_TOPGEN], 1u);
      else XB_SPIN(xb_ld(&bar[XB_TOPGEN]) == tg, bar);
      __builtin_amdgcn_fence(__ATOMIC_ACQUIRE, "agent");
      xb_add(&bar[XB_XGEN(b.x)], 1u);
      asm volatile("s_waitcnt vmcnt(0)" ::: "memory");
    } else {
      XB_SPIN(xb_ld(&bar[XB_XGEN(b.x)]) == gen, bar);
      __builtin_amdgcn_fence(__ATOMIC_ACQUIRE, "agent");
      asm volatile("s_waitcnt vmcnt(0)" ::: "memory");
    }
  }
  __syncthreads();
}

__global__ void __launch_bounds__(256, 2) hymba_fwd(Params p) {
  __shared__ __attribute__((aligned(16))) char smem[SMEM_BYTES];
  __shared__ uint4 xb_words;
  if (threadIdx.x == 0) xb_words = make_uint4(0u, 0u, 0u, 0u);
  __syncthreads();
  const XcdBarrier xb = xcd_barrier_post((unsigned*)(p.ws + OFF_XB), (volatile unsigned*)&xb_words);
  if (p.ws == nullptr) cg::this_grid().sync();
  phase_prep(p, smem);
  xcd_barrier(xb);
  thin_tasks(p);
  gemm_phase<false>(p, smem);
  xcd_barrier(xb);
  phase_mixers(p, smem);
  xcd_barrier(xb);
  gemm_phase<true>(p, smem);
}

extern "C" void kernel_launch(void* const* d_in, const int* in_sizes, int n_in, void* d_out, int out_size, void* d_ws, size_t ws_size, hipStream_t stream) {
  static int grid_blocks = 0;
  if (!grid_blocks) {
    int dev = 0, cus = 0, per_cu = 0;
    hipGetDevice(&dev);
    hipDeviceGetAttribute(&cus, hipDeviceAttributeMultiprocessorCount, dev);
    hipOccupancyMaxActiveBlocksPerMultiprocessor(&per_cu, hymba_fwd, 256, 0);
    if (per_cu > 2) per_cu = 2;
    if (per_cu < 1) per_cu = 1;
    grid_blocks = cus * per_cu;
    grid_blocks &= ~7;
    if (ws_size < WS_END) fprintf(stderr, "workspace too small: %zu < %zu\n", ws_size, (size_t)WS_END);
  }
  Params p{};
  p.x = (const float*)d_in[0]; p.meta = (const float*)d_in[1]; p.norm_g = (const float*)d_in[2]; p.w_in = (const float*)d_in[3];
  p.b_f = (const float*)d_in[4]; p.w_out = (const float*)d_in[5]; p.final_g = (const float*)d_in[6];
  p.out = (float*)d_out; p.ws = (unsigned char*)d_ws;
  hipMemsetAsync((char*)d_ws + OFF_CTR, 0, (OFF_XB - OFF_CTR) + XCD_BAR_WORDS * 4, stream);
  void* args[] = {&p};
  hipError_t e = hipLaunchCooperativeKernel((void*)hymba_fwd, dim3(grid_blocks), dim3(256), args, 0, stream);
  if (e != hipSuccess) fprintf(stderr, "cooperative launch failed: %s (grid %d)\n", hipGetErrorString(e), grid_blocks);
}
```

```cpp
#include <hip/hip_runtime.h>
#include <hip/hip_cooperative_groups.h>
#include <stdint.h>
#include <stdio.h>
#include <type_traits>
namespace cg = cooperative_groups;

typedef __attribute__((ext_vector_type(8))) short bf16x8;
typedef __attribute__((ext_vector_type(16))) float f32x16;
typedef __attribute__((ext_vector_type(4))) float f32x4;
typedef __attribute__((ext_vector_type(2))) float f32x2;
typedef __attribute__((ext_vector_type(2))) __bf16 bf2_t;
typedef unsigned short bf16_t;
#define LOG2E_F 1.4426950408889634f

#define DI __device__ __forceinline__

constexpr int BATCH = 8, SEQ = 2048, DM = 1024, NMETA = 16, LTOK = 2064;
constexpr int MSEQ = BATCH * SEQ;
constexpr int MROWS = MSEQ + NMETA;
constexpr int NIN = 7184;
constexpr int NMAIN = 7168;
constexpr float EPS = 1e-6f;
constexpr float LOG2E = 1.4426950408889634f;
constexpr float QSCALE = 0.125f * LOG2E;
constexpr float DKS = 0.08838834764831845f;
constexpr float BIG = 1e30f;
constexpr int PCENTER = 1032;

constexpr size_t al256(size_t x) { return (x + 255) & ~(size_t)255; }
constexpr size_t OFF_RQ = 0;
constexpr size_t OFF_RK = al256(OFF_RQ + (size_t)MSEQ * 512 * 2);
constexpr size_t OFF_RVT = al256(OFF_RK + (size_t)MROWS * 512 * 2);
constexpr size_t OFF_RVTM = al256(OFF_RVT + (size_t)BATCH * 4 * 256 * 2048 * 2);
constexpr size_t OFF_RG = al256(OFF_RVTM + (size_t)4 * 256 * 16 * 2);
constexpr size_t OFF_FQ = al256(OFF_RG + (size_t)MSEQ * 1024 * 2);
constexpr size_t OFF_FK = al256(OFF_FQ + (size_t)MSEQ * 1024 * 2);
constexpr size_t OFF_FVT = al256(OFF_FK + (size_t)MROWS * 1024 * 2);
constexpr size_t OFF_FVTM = al256(OFF_FVT + (size_t)BATCH * 16 * 64 * 2048 * 2);
constexpr size_t OFF_FG = al256(OFF_FVTM + (size_t)16 * 64 * 16 * 2);
constexpr size_t OFF_LF = al256(OFF_FG + (size_t)MSEQ * 1024 * 2);
constexpr size_t OFF_LFM = al256(OFF_LF + (size_t)BATCH * 16 * 2048 * 4);
constexpr size_t OFF_WOT = al256(OFF_LFM + 16 * 16 * 4);
constexpr size_t OFF_COS = al256(OFF_WOT + (size_t)1024 * 2048 * 2);
constexpr size_t OFF_SIN = al256(OFF_COS + (size_t)LTOK * 64 * 4);
constexpr size_t OFF_CTR = al256(OFF_SIN + (size_t)LTOK * 64 * 4);
constexpr size_t OFF_XB = al256(OFF_CTR + 1024);
constexpr size_t OFF_EXCH = al256(OFF_XB + 16384);
constexpr size_t WS_END = OFF_EXCH + (size_t)64 * 8 * 256 * 4;
constexpr size_t OUT_U = 0;
constexpr size_t OUT_WINT = al256((size_t)MROWS * 1024 * 2);
static_assert(OUT_WINT + (size_t)NIN * 1024 * 2 <= (size_t)MSEQ * 1024 * 4, "d_out scratch overflow");
static_assert(WS_END <= (size_t)256 * 1024 * 1024, "workspace overflow");

constexpr int SMEM_BYTES = 73728 + 1024;

struct Params {
  const float* x; const float* meta; const float* norm_g; const float* w_in; const float* b_f; const float* w_out; const float* final_g;
  float* out; unsigned char* ws;
};

DI unsigned pack2(float a, float b) { f32x2 v = {a, b}; bf2_t r = __builtin_convertvector(v, bf2_t); return __builtin_bit_cast(unsigned, r); }
DI bf16_t f2bf(float a) { return (bf16_t)(pack2(a, 0.f) & 0xffffu); }
DI float bflo(unsigned u) { return __uint_as_float(u << 16); }
DI float bfhi(unsigned u) { return __uint_as_float(u & 0xffff0000u); }
DI float silu(float v) { return v * __builtin_amdgcn_rcpf(1.f + __builtin_amdgcn_exp2f(-LOG2E_F * v)); }
DI float wave_sum(float v) {
#pragma unroll
  for (int o = 32; o > 0; o >>= 1) v += __shfl_xor(v, o);
  return v;
}
DI f32x16 zero16() { f32x16 z;
#pragma unroll
  for (int i = 0; i < 16; ++i) z[i] = 0.f; return z; }
#define MFMA32(a, b, c) __builtin_amdgcn_mfma_f32_32x32x16_bf16((a), (b), (c), 0, 0, 0)
#define MFMA16(a, b, c) __builtin_amdgcn_mfma_f32_16x16x32_bf16((a), (b), (c), 0, 0, 0)
DI float xhalf_max(float v) { const unsigned u = __float_as_uint(v); auto r = __builtin_amdgcn_permlane32_swap(u, u, false, false); return fmaxf(__uint_as_float(r[0]), __uint_as_float(r[1])); }
DI float xhalf_sum(float v) { const unsigned u = __float_as_uint(v); auto r = __builtin_amdgcn_permlane32_swap(u, u, false, false); return __uint_as_float(r[0]) + __uint_as_float(r[1]); }
DI float lg2gamma(int h) { return log2f(1.f - exp2f(-5.f - (float)h)); }

DI void transpose_to_bf16(const float* __restrict__ src, bf16_t* __restrict__ dst, int K, int N, float* tile  ) {
  const int tid = threadIdx.x;
  const int kts = K / 64, nts = (N + 63) / 64, ntile = kts * nts;
  const int r0 = tid >> 4, c4 = tid & 15;
  float4 v[4];
  auto load = [&](int t) {
    const int kt = t % kts, nt = t / kts;
    const int n = nt * 64 + c4 * 4;
#pragma unroll
    for (int ps = 0; ps < 4; ++ps) {
      v[ps] = make_float4(0.f, 0.f, 0.f, 0.f);
      if (n < N) { const f32x4 t_ = __builtin_nontemporal_load((const f32x4*)(src + (size_t)(kt * 64 + r0 + 16 * ps) * N + n)); v[ps] = make_float4(t_[0], t_[1], t_[2], t_[3]); }
    }
  };
  int t = blockIdx.x;
  if (t < ntile) load(t);
  for (; t < ntile; t += gridDim.x) {
    const int kt = t % kts, nt = t / kts;
#pragma unroll
    for (int ps = 0; ps < 4; ++ps) {
      float* tp = tile + (r0 + 16 * ps) * 65 + c4 * 4;
      tp[0] = v[ps].x; tp[1] = v[ps].y; tp[2] = v[ps].z; tp[3] = v[ps].w;
    }
    if (t + (int)gridDim.x < ntile) load(t + gridDim.x);
    __syncthreads();
#pragma unroll
    for (int ps = 0; ps < 2; ++ps) {
      const int nr = (tid >> 3) + 32 * ps, kc = tid & 7;
      const int n = nt * 64 + nr;
      if (n < N) {
        const float* tp = tile + (kc * 8) * 65 + nr;
        uint4 o;
        o.x = pack2(tp[0 * 65], tp[1 * 65]); o.y = pack2(tp[2 * 65], tp[3 * 65]);
        o.z = pack2(tp[4 * 65], tp[5 * 65]); o.w = pack2(tp[6 * 65], tp[7 * 65]);
        *(uint4*)(dst + (size_t)n * K + kt * 64 + kc * 8) = o;
      }
    }
    __syncthreads();
  }
}

DI void phase_prep(const Params& p, char* smem) {
  const int tid = threadIdx.x, lane = tid & 63, wave = tid >> 6;
  const int gw = blockIdx.x * 4 + wave, nw = gridDim.x * 4;
  bf16_t* U = (bf16_t*)((char*)p.out + OUT_U);
  {
    float4 v[4], nx[4];
    int r = gw;
    if (r < MROWS) {
      const float* src = r < MSEQ ? p.x + (size_t)r * DM : p.meta + (size_t)(r - MSEQ) * DM;
#pragma unroll
      for (int q = 0; q < 4; ++q) { const f32x4 t_ = __builtin_nontemporal_load((const f32x4*)src + q * 64 + lane); v[q] = make_float4(t_[0], t_[1], t_[2], t_[3]); }
    }
    float4 g[4];
#pragma unroll
    for (int q = 0; q < 4; ++q) g[q] = ((const float4*)p.norm_g)[q * 64 + lane];
    for (; r < MROWS; r += nw) {
      const int rn = r + nw;
      if (rn < MROWS) {
        const float* src = rn < MSEQ ? p.x + (size_t)rn * DM : p.meta + (size_t)(rn - MSEQ) * DM;
#pragma unroll
        for (int q = 0; q < 4; ++q) { const f32x4 t_ = __builtin_nontemporal_load((const f32x4*)src + q * 64 + lane); nx[q] = make_float4(t_[0], t_[1], t_[2], t_[3]); }
      }
      float ss = 0.f;
#pragma unroll
      for (int q = 0; q < 4; ++q) ss += v[q].x * v[q].x + v[q].y * v[q].y + v[q].z * v[q].z + v[q].w * v[q].w;
      ss = wave_sum(ss);
      const float rstd = rsqrtf(ss * (1.f / DM) + EPS);
#pragma unroll
      for (int q = 0; q < 4; ++q) {
        uint2 o; o.x = pack2(v[q].x * rstd * g[q].x, v[q].y * rstd * g[q].y); o.y = pack2(v[q].z * rstd * g[q].z, v[q].w * rstd * g[q].w);
        *(uint2*)(U + (size_t)r * DM + (q * 64 + lane) * 4) = o;
      }
#pragma unroll
      for (int q = 0; q < 4; ++q) v[q] = nx[q];
    }
  }
  transpose_to_bf16(p.w_in, (bf16_t*)((char*)p.out + OUT_WINT), DM, NIN, (float*)smem);
  transpose_to_bf16(p.w_out, (bf16_t*)(p.ws + OFF_WOT), 2048, DM, (float*)smem);
  const int gt = blockIdx.x * 256 + tid, nt = gridDim.x * 256;
  float* ct = (float*)(p.ws + OFF_COS); float* st = (float*)(p.ws + OFF_SIN);
  for (int i = gt; i < LTOK * 64; i += nt) {
    const int l = i >> 6, j = i & 63;
    const float inv = (float)exp(-(double)j * (1.0 / 64.0) * 9.210340371976184);
    const float ang = (float)l * inv;
    double t = (double)ang * 0.15915494309189535; t -= rint(t);
    ct[i] = __builtin_amdgcn_cosf((float)t); st[i] = __builtin_amdgcn_sinf((float)t);
  }
}

DI float log_sigmoid(float v) { return v >= 0.f ? -log1pf(expf(-v)) : v - log1pf(expf(v)); }

DI void thin_tasks(const Params& p) {
  const int tid = threadIdx.x, lane = tid & 63, wave = tid >> 6;
  const int gw = blockIdx.x * 4 + wave, nw = gridDim.x * 4;
  const bf16_t* U = (const bf16_t*)((const char*)p.out + OUT_U);
  const bf16_t* WT = (const bf16_t*)((const char*)p.out + OUT_WINT);
  const int l16 = lane & 15, q4 = lane >> 4;
  for (int task = gw; task < 1025 + 112; task += nw) {
    if (task < 1025) {
      const int r0 = task * 16;
      const bf16_t* ap = U + (size_t)(r0 + l16) * DM + q4 * 8;
      const bf16_t* bp = WT + (size_t)(NMAIN + l16) * DM + q4 * 8;
      f32x4 acc = {0.f, 0.f, 0.f, 0.f};
#pragma unroll 8
      for (int ks = 0; ks < 32; ++ks) {
        const bf16x8 a = *(const bf16x8*)(ap + ks * 32), b = *(const bf16x8*)(bp + ks * 32);
        acc = MFMA16(a, b, acc);
      }
      const float bias = p.b_f[l16];
      float4 o;
      o.x = log_sigmoid(acc[0] + bias) * LOG2E; o.y = log_sigmoid(acc[1] + bias) * LOG2E;
      o.z = log_sigmoid(acc[2] + bias) * LOG2E; o.w = log_sigmoid(acc[3] + bias) * LOG2E;
      if (task < 1024) {
        const int b = r0 >> 11, s = (r0 & 2047) + q4 * 4;
        *(float4*)((float*)(p.ws + OFF_LF) + (size_t)(b * 16 + l16) * 2048 + s) = o;
      } else {
        *(float4*)((float*)(p.ws + OFF_LFM) + l16 * 16 + q4 * 4) = o;
      }
    } else {
      const int mtk = task - 1025, tl = mtk >> 2, pr = mtk & 3;
      const int nt = tl < 4 ? 4 + tl : tl < 12 ? 8 + (tl - 4) : tl < 20 ? 32 + (tl - 12) : 40 + (tl - 20);
      const int jA = 16 * pr + l16;
      const bf16_t* ap = U + (size_t)(MSEQ + l16) * DM + q4 * 8;
      const bf16_t* bp0 = WT + (size_t)(nt * 128 + jA) * DM + q4 * 8;
      const bf16_t* bp1 = bp0 + (size_t)64 * DM;
      f32x4 a0 = {0.f, 0.f, 0.f, 0.f}, a1 = {0.f, 0.f, 0.f, 0.f};
#pragma unroll 4
      for (int ks = 0; ks < 32; ++ks) {
        const bf16x8 a = *(const bf16x8*)(ap + ks * 32);
        const bf16x8 b0 = *(const bf16x8*)(bp0 + ks * 32), b1 = *(const bf16x8*)(bp1 + ks * 32);
        a0 = MFMA16(a, b0, a0); a1 = MFMA16(a, b1, a1);
      }
      const int m0 = q4 * 4;
      if (nt < 8) {
        const int h = nt - 4; const float lg = lg2gamma(h);
        bf16_t* RK = (bf16_t*)(p.ws + OFF_RK);
        const float* ct = (const float*)(p.ws + OFF_COS); const float* sn = (const float*)(p.ws + OFF_SIN);
#pragma unroll
        for (int i = 0; i < 4; ++i) {
          const int m = m0 + i;
          const float c = ct[m * 64 + jA], s = sn[m * 64 + jA];
          const float sc = DKS * exp2f(-(float)(m - PCENTER) * lg);
          bf16_t* d = RK + (size_t)(MSEQ + m) * 512 + h * 128 + jA;
          d[0] = f2bf((a0[i] * c - a1[i] * s) * sc); d[64] = f2bf((a0[i] * s + a1[i] * c) * sc);
        }
      } else if (nt < 16) {
        const int c0 = (nt - 8) * 128 + jA, c1 = c0 + 64;
        bf16_t* V = (bf16_t*)(p.ws + OFF_RVTM);
        uint2 o; o.x = pack2(a0[0], a0[1]); o.y = pack2(a0[2], a0[3]);
        *(uint2*)(V + (size_t)c0 * 16 + m0) = o;
        o.x = pack2(a1[0], a1[1]); o.y = pack2(a1[2], a1[3]);
        *(uint2*)(V + (size_t)c1 * 16 + m0) = o;
      } else if (nt < 40) {
        bf16_t* FK = (bf16_t*)(p.ws + OFF_FK);
        const int c0 = (nt - 32) * 128 + jA;
#pragma unroll
        for (int i = 0; i < 4; ++i) { bf16_t* d = FK + (size_t)(MSEQ + m0 + i) * 1024 + c0; d[0] = f2bf(a0[i]); d[64] = f2bf(a1[i]); }
      } else {
        const int c0 = (nt - 40) * 128 + jA, c1 = c0 + 64;
        bf16_t* V = (bf16_t*)(p.ws + OFF_FVTM);
        uint2 o; o.x = pack2(a0[0], a0[1]); o.y = pack2(a0[2], a0[3]);
        *(uint2*)(V + (size_t)c0 * 16 + m0) = o;
        o.x = pack2(a1[0], a1[1]); o.y = pack2(a1[2], a1[3]);
        *(uint2*)(V + (size_t)c1 * 16 + m0) = o;
      }
    }
  }
}

constexpr int GS = 64;
constexpr int GA = 256 * GS, GB = 128 * GS;
constexpr int GSTAGE = GA + GB;

template <bool OUTP>
DI void gemm_phase(const Params& p, char* smem) {
  constexpr int KT = OUTP ? 64 : 32;
  constexpr int SNT = OUTP ? 1 : 7;
  constexpr int NSUP = 8 * SNT;
  constexpr int SPX = NSUP / 8;
  const int xcd = blockIdx.x & 7, loc = blockIdx.x >> 3, nloc = gridDim.x >> 3;
  const int tid = threadIdx.x, lane = tid & 63, wave = tid >> 6;
  const int l32 = lane & 31, hl = lane >> 5;
  const int wm = wave >> 1, wn = wave & 1;
  const bf16_t* Ab0; const bf16_t* Ab1; const bf16_t* Bb; int ldb;
  if (OUTP) { Ab0 = (const bf16_t*)(p.ws + OFF_RG); Ab1 = (const bf16_t*)(p.ws + OFF_FG); Bb = (const bf16_t*)(p.ws + OFF_WOT); ldb = 2048; }
  else { Ab0 = Ab1 = (const bf16_t*)((const char*)p.out + OUT_U); Bb = (const bf16_t*)((const char*)p.out + OUT_WINT); ldb = 1024; }
  float* ssl = (float*)(smem + 3 * GSTAGE);

  unsigned aoff[4], boff[2];
  auto set_tile = [&](int i) {
    const int s = xcd * SPX + (i >> 6), in = i & 63;
    const int mt_ = (s / SNT) * 8 + (in >> 3), nt_ = (s % SNT) * 8 + (in & 7);
    const int r16 = lane >> 2, pc = lane & 3;
#pragma unroll
    for (int j = 0; j < 4; ++j) { const int row = (wave * 4 + j) * 16 + r16; aoff[j] = (unsigned)(((mt_ * 256 + row) * 1024 + (pc ^ ((row >> 2) & 3)) * 8) * 2); }
#pragma unroll
    for (int j = 0; j < 2; ++j) { const int row = (wave * 2 + j) * 16 + r16; boff[j] = (unsigned)(((nt_ * 128 + row) * ldb + (pc ^ ((row >> 2) & 3)) * 8) * 2); }
  };
  auto dma = [&](int kt, int stg) {
    const int k0 = kt * 32;
    const char* Ak = (const char*)(OUTP ? (k0 < 1024 ? Ab0 : Ab1) : Ab0) + (OUTP ? (k0 & 1023) : k0) * 2;
    const char* Bk = (const char*)Bb + k0 * 2;
    char* As = smem + stg * GSTAGE + wave * 4096 + lane * 16; char* Bs = smem + stg * GSTAGE + GA + wave * 2048 + lane * 16;
#pragma unroll
    for (int j = 0; j < 4; ++j)
      __builtin_amdgcn_global_load_lds((const unsigned*)(Ak + aoff[j]), (__attribute__((address_space(3))) unsigned*)(As + j * 1024), 16, 0, 0);
#pragma unroll
    for (int j = 0; j < 2; ++j)
      __builtin_amdgcn_global_load_lds((const unsigned*)(Bk + boff[j]), (__attribute__((address_space(3))) unsigned*)(Bs + j * 1024), 16, 0, 0);
  };
  const int fsw = (l32 >> 2) & 3;
  const int cof0 = ((0 + hl) ^ fsw) * 16, cof1 = ((2 + hl) ^ fsw) * 16;

  __syncthreads();
  int ti = loc;
  if (!OUTP && ti < SPX * 64) { set_tile(ti); dma(0, 0); dma(1, 1); }
#pragma unroll 1
  for (; ti < SPX * 64; ti += nloc) {
  if (OUTP) { set_tile(ti); dma(0, 0); dma(1, 1); }
  const int s_ = xcd * SPX + (ti >> 6), in_ = ti & 63;
  const int mt = (s_ / SNT) * 8 + (in_ >> 3), nt = (s_ % SNT) * 8 + (in_ & 7);
  const int m0 = mt * 256, n0 = nt * 128;
  if (OUTP) ssl[tid] = 0.f;

  f32x16 acc[4][2];
#pragma unroll
  for (int a = 0; a < 4; ++a)
#pragma unroll
    for (int b = 0; b < 2; ++b) acc[a][b] = zero16();

  typedef __attribute__((ext_vector_type(4))) unsigned u32x4_t;
  const unsigned lds_base = (unsigned)(size_t)smem;
  const unsigned a_rd = lds_base + (unsigned)((wm * 128 + l32) * GS), b_rd = lds_base + (unsigned)(GA + (wn * 32 + l32) * GS);
  u32x4_t a0, a1, a2, a3, b0, b1, c0, c1, c2, c3, d0, d1;
  auto issue_reads = [&](int stg) {
    const unsigned so = (unsigned)(stg * GSTAGE);
    const unsigned aa0 = a_rd + so + cof0, bb0 = b_rd + so + cof0, aa1 = a_rd + so + cof1, bb1 = b_rd + so + cof1;
    asm volatile(
        "ds_read_b128 %0, %12\n\t"
        "ds_read_b128 %1, %12 offset:2048\n\t"
        "ds_read_b128 %2, %12 offset:4096\n\t"
        "ds_read_b128 %3, %12 offset:6144\n\t"
        "ds_read_b128 %4, %13\n\t"
        "ds_read_b128 %5, %13 offset:4096\n\t"
        "ds_read_b128 %6, %14\n\t"
        "ds_read_b128 %7, %14 offset:2048\n\t"
        "ds_read_b128 %8, %14 offset:4096\n\t"
        "ds_read_b128 %9, %14 offset:6144\n\t"
        "ds_read_b128 %10, %15\n\t"
        "ds_read_b128 %11, %15 offset:4096"
        : "=&v"(a0), "=&v"(a1), "=&v"(a2), "=&v"(a3), "=&v"(b0), "=&v"(b1), "=&v"(c0), "=&v"(c1), "=&v"(c2), "=&v"(c3), "=&v"(d0), "=&v"(d1)
        : "v"(aa0), "v"(bb0), "v"(aa1), "v"(bb1)
        : "memory");
  };
  auto mfmas = [&]() {
#define BF(x) __builtin_bit_cast(bf16x8, x)
    asm volatile("s_waitcnt lgkmcnt(6)" : "+v"(a0), "+v"(a1), "+v"(a2), "+v"(a3), "+v"(b0), "+v"(b1), "+v"(c0), "+v"(c1), "+v"(c2), "+v"(c3), "+v"(d0), "+v"(d1) :: "memory");
    acc[0][0] = MFMA32(BF(a0), BF(b0), acc[0][0]); acc[0][1] = MFMA32(BF(a0), BF(b1), acc[0][1]);
    acc[1][0] = MFMA32(BF(a1), BF(b0), acc[1][0]); acc[1][1] = MFMA32(BF(a1), BF(b1), acc[1][1]);
    acc[2][0] = MFMA32(BF(a2), BF(b0), acc[2][0]); acc[2][1] = MFMA32(BF(a2), BF(b1), acc[2][1]);
    acc[3][0] = MFMA32(BF(a3), BF(b0), acc[3][0]); acc[3][1] = MFMA32(BF(a3), BF(b1), acc[3][1]);
    asm volatile("s_waitcnt lgkmcnt(0)" : "+v"(c0), "+v"(c1), "+v"(c2), "+v"(c3), "+v"(d0), "+v"(d1) :: "memory");
    acc[0][0] = MFMA32(BF(c0), BF(d0), acc[0][0]); acc[0][1] = MFMA32(BF(c0), BF(d1), acc[0][1]);
    acc[1][0] = MFMA32(BF(c1), BF(d0), acc[1][0]); acc[1][1] = MFMA32(BF(c1), BF(d1), acc[1][1]);
    acc[2][0] = MFMA32(BF(c2), BF(d0), acc[2][0]); acc[2][1] = MFMA32(BF(c2), BF(d1), acc[2][1]);
    acc[3][0] = MFMA32(BF(c3), BF(d0), acc[3][0]); acc[3][1] = MFMA32(BF(c3), BF(d1), acc[3][1]);
#undef BF
  };
  asm volatile("s_waitcnt vmcnt(0)" ::: "memory");
  __syncthreads();
  int stg = 0;
#pragma unroll 1
  for (int kt = 0; kt < KT; ++kt) {
    const bool more = kt + 2 < KT;
    issue_reads(stg);
    if (more) dma(kt + 2, stg == 0 ? 2 : stg - 1);
    mfmas();
    if (more) asm volatile("s_waitcnt vmcnt(6)" ::: "memory");
    else asm volatile("s_waitcnt vmcnt(0)" ::: "memory");
    __builtin_amdgcn_s_barrier();
    stg = stg == 2 ? 0 : stg + 1;
  }
  if (!OUTP && ti + nloc < SPX * 64) { set_tile(ti + nloc); dma(0, 0); dma(1, 1); }

  const int cl = wn * 32 + l32;
  if (OUTP) {
    const char* xb = (const char*)p.x; char* ob = (char*)p.out;
    const int rl0 = wm * 128 + 4 * hl;
    const unsigned off0 = (unsigned)(((m0 + rl0) * DM + n0 + cl) * 4);
#pragma unroll
    for (int mi = 0; mi < 4; ++mi)
#pragma unroll
      for (int i = 0; i < 16; ++i) {
        const int dr = mi * 32 + 8 * (i >> 2) + (i & 3);
        const unsigned off = off0 + (unsigned)(dr * DM * 4);
        const float h0 = __builtin_nontemporal_load((const float*)(xb + off)) + acc[mi][0][i], h1 = __builtin_nontemporal_load((const float*)(xb + off + 256)) + acc[mi][1][i];
        acc[mi][0][i] = h0; acc[mi][1][i] = h1;
        atomicAdd(&ssl[rl0 + dr], h0 * h0 + h1 * h1);
        if ((i & 7) == 7) asm volatile("" ::: "memory");
      }
    __syncthreads();
    float* exch = (float*)(p.ws + OFF_EXCH) + (size_t)mt * 8 * 256;
    unsigned* flag = (unsigned*)(p.ws + OFF_CTR) + 64 + mt;
    __hip_atomic_store(exch + nt * 256 + tid, ssl[tid], __ATOMIC_RELAXED, __HIP_MEMORY_SCOPE_AGENT);
    asm volatile("s_waitcnt vmcnt(0)" ::: "memory");
    __syncthreads();
    if (tid == 0) {
      __hip_atomic_fetch_add(flag, 1u, __ATOMIC_RELAXED, __HIP_MEMORY_SCOPE_AGENT);
      while (__hip_atomic_load(flag, __ATOMIC_RELAXED, __HIP_MEMORY_SCOPE_AGENT) < 8u) __builtin_amdgcn_s_sleep(1);
    }
    __syncthreads();
    {
      float tot = 0.f;
#pragma unroll
      for (int c = 0; c < 8; ++c) tot += __hip_atomic_load(exch + c * 256 + tid, __ATOMIC_RELAXED, __HIP_MEMORY_SCOPE_AGENT);
      ssl[tid] = rsqrtf(tot * (1.f / DM) + EPS);
    }
    __syncthreads();
    const float g0 = p.final_g[n0 + cl], g1 = p.final_g[n0 + cl + 64];
#pragma unroll
    for (int mi = 0; mi < 4; ++mi)
#pragma unroll
      for (int i = 0; i < 16; ++i) {
        const int dr = mi * 32 + 8 * (i >> 2) + (i & 3);
        const unsigned off = off0 + (unsigned)(dr * DM * 4);
        const float rs = ssl[rl0 + dr];
        __builtin_nontemporal_store(acc[mi][0][i] * rs * g0, (float*)(ob + off)); __builtin_nontemporal_store(acc[mi][1][i] * rs * g1, (float*)(ob + off + 256));
      }
    __syncthreads();
  } else {
    if (nt < 8) {
      const int h = nt & 3; const float lg = lg2gamma(h);
      const bool isq = nt < 4;
      char* dbase = isq ? (char*)(p.ws + OFF_RQ) : (char*)(p.ws + OFF_RK);
      const float* ct = (const float*)(p.ws + OFF_COS); const float* sn = (const float*)(p.ws + OFF_SIN);
      const int rb = m0 + wm * 128 + 4 * hl;
      const unsigned off0 = (unsigned)((rb * 512 + h * 128 + cl) * 2);
      const float sgn = isq ? lg : -lg, mul = isq ? 1.f : DKS;
#pragma unroll
      for (int mi = 0; mi < 4; ++mi)
#pragma unroll
        for (int i = 0; i < 16; ++i) {
          const int dr = mi * 32 + 8 * (i >> 2) + (i & 3);
          const int pos = NMETA + ((rb + dr) & 2047);
          const float c = ct[pos * 64 + cl], s = sn[pos * 64 + cl];
          const float sc = mul * __builtin_amdgcn_exp2f((float)(pos - PCENTER) * sgn);
          const float x1 = acc[mi][0][i], x2 = acc[mi][1][i];
          const unsigned u = pack2((x1 * c - x2 * s) * sc, (x1 * s + x2 * c) * sc);
          char* d = dbase + (off0 + (unsigned)(dr * 1024));
          *(bf16_t*)d = (bf16_t)u; *(bf16_t*)(d + 128) = (bf16_t)(u >> 16);
          if ((i & 7) == 7) asm volatile("" ::: "memory");
        }
    } else if ((nt >= 8 && nt < 16) || (nt >= 40 && nt < 48)) {
      const bool isr = nt < 16;
      bf16_t* V = isr ? (bf16_t*)(p.ws + OFF_RVT) : (bf16_t*)(p.ws + OFF_FVT);
      const int b = m0 >> 11;
#pragma unroll
      for (int ni = 0; ni < 2; ++ni) {
        const int c = (isr ? (nt - 8) : (nt - 40)) * 128 + cl + 64 * ni;
        bf16_t* vrow = V + ((size_t)b * 1024 + c) * 2048 + (m0 & 2047);
#pragma unroll
        for (int mi = 0; mi < 4; ++mi) {
          uint2 o[4];
#pragma unroll
          for (int g = 0; g < 4; ++g) { o[g].x = pack2(acc[mi][ni][4 * g], acc[mi][ni][4 * g + 1]); o[g].y = pack2(acc[mi][ni][4 * g + 2], acc[mi][ni][4 * g + 3]); }
#pragma unroll
          for (int k = 0; k < 4; k += 2) {
            auto r0 = __builtin_amdgcn_permlane32_swap(o[k].x, o[k + 1].x, false, false);
            auto r1 = __builtin_amdgcn_permlane32_swap(o[k].y, o[k + 1].y, false, false);
            *(uint4*)(vrow + wm * 128 + mi * 32 + 8 * k + 8 * hl) = make_uint4(r0[0], r1[0], r0[1], r1[1]);
          }
        }
      }
    } else {
      char* dbase; int cb; int mode;
      if (nt < 24) { dbase = (char*)(p.ws + OFF_RG); cb = (nt - 16) * 128; mode = 0; }
      else if (nt < 32) { dbase = (char*)(p.ws + OFF_FQ); cb = (nt - 24) * 128; mode = 1; }
      else if (nt < 40) { dbase = (char*)(p.ws + OFF_FK); cb = (nt - 32) * 128; mode = 2; }
      else { dbase = (char*)(p.ws + OFF_FG); cb = (nt - 48) * 128; mode = 0; }
      const unsigned off0 = (unsigned)(((m0 + wm * 128 + 4 * hl) * 1024 + cb + cl) * 2);
#define ROWMAJOR_STORE(EXPR0, EXPR1) \
      _Pragma("unroll") for (int mi = 0; mi < 4; ++mi) \
      _Pragma("unroll") for (int i = 0; i < 16; ++i) { \
        const float a0 = acc[mi][0][i], a1 = acc[mi][1][i]; \
        const unsigned u = pack2(EXPR0, EXPR1); \
        char* d = dbase + (off0 + (unsigned)((mi * 32 + 8 * (i >> 2) + (i & 3)) * 2048)); \
        *(bf16_t*)d = (bf16_t)u; *(bf16_t*)(d + 128) = (bf16_t)(u >> 16); \
      }
      if (mode == 0) { ROWMAJOR_STORE(silu(a0), silu(a1)) }
      else if (mode == 1) { ROWMAJOR_STORE(a0 * QSCALE, a1 * QSCALE) }
      else { ROWMAJOR_STORE(a0, a1) }
#undef ROWMAJOR_STORE
    }
  }
  }
}

DI int kperm(int m) { return 16 * (m >> 4) + 8 * ((m >> 2) & 1) + 4 * ((m >> 3) & 1) + (m & 3); }

template <bool FOX>
struct MixCfg {
  static constexpr int DK = FOX ? 64 : 128, DV = FOX ? 64 : 256, NH = FOX ? 16 : 4;
  static constexpr int TK = FOX ? 64 : 32;
  static constexpr int KSTR = (DK + 8) * 2, VSTR = TK * 2 + 16;
  static constexpr int NKS = DK / 16, NMB = FOX ? 2 : 4, KCH = DK / 8, VCH = TK / 8, NKB = TK / 32;
  static constexpr int QLD = FOX ? 1024 : 512;
  static constexpr int QPB = FOX ? 128 : 64;
  static constexpr int NKL = TK * KCH / 256, NVL = DV * VCH / 256;
  static constexpr int STAGE = TK * KSTR + DV * VSTR;
  static constexpr int PADK = TK - 16;
};

template <bool FOX>
DI void mixer_sub(const Params& p, char* smem, int b, int h, int qi) {
  typedef MixCfg<FOX> C;
  constexpr int DK = C::DK, DV = C::DV, NH = C::NH, TK = C::TK, KSTR = C::KSTR, VSTR = C::VSTR, NKS = C::NKS, NMB = C::NMB;
  constexpr int KCH = C::KCH, VCH = C::VCH, NKB = C::NKB, QLD = C::QLD, QPB = C::QPB, PADK = C::PADK;
  float* c2 = (float*)(smem + 2 * C::STAGE);
  const int tid = threadIdx.x, lane = tid & 63, wave = tid >> 6, l32 = lane & 31, hl = lane >> 5;
  const int qg = FOX ? wave : (wave & 1), dh = FOX ? 0 : (wave >> 1);
  const bf16_t* Qg = FOX ? (const bf16_t*)(p.ws + OFF_FQ) : (const bf16_t*)(p.ws + OFF_RQ);
  const bf16_t* Kg = FOX ? (const bf16_t*)(p.ws + OFF_FK) : (const bf16_t*)(p.ws + OFF_RK);
  const bf16_t* Vg = FOX ? (const bf16_t*)(p.ws + OFF_FVT) : (const bf16_t*)(p.ws + OFF_RVT);
  const bf16_t* Vm = FOX ? (const bf16_t*)(p.ws + OFF_FVTM) : (const bf16_t*)(p.ws + OFF_RVTM);
  bf16_t* Gg = FOX ? (bf16_t*)(p.ws + OFF_FG) : (bf16_t*)(p.ws + OFF_RG);

  const int eq0 = TK + qi * QPB + qg * 32;

  const int qrow = b * 2048 + qi * QPB + qg * 32 + l32;
  bf16x8 qf[NKS];
  {
    const bf16_t* qp = Qg + (size_t)qrow * QLD + h * DK + hl * 8;
#pragma unroll
    for (int ks = 0; ks < NKS; ++ks) qf[ks] = *(const bf16x8*)(qp + ks * 16);
  }
  f32x16 O[NMB];
#pragma unroll
  for (int mb = 0; mb < NMB; ++mb) O[mb] = zero16();
  float mrun = -BIG, lrun = 0.f;

  const int NT = 1 + QPB * (qi + 1) / TK;
  const int prow = kperm(l32);
  constexpr int NSET = FOX ? 2 : 1;
  uint4 pk[NSET][C::NKL], pv[NSET][C::NVL];
  typedef std::integral_constant<int, 0> I0; typedef std::integral_constant<int, 1> I1;
  const unsigned char* wsb = p.ws;
  constexpr unsigned KOFF = (unsigned)(FOX ? OFF_FK : OFF_RK), VOFF = (unsigned)(FOX ? OFF_FVT : OFF_RVT), VMOFF = (unsigned)(FOX ? OFF_FVTM : OFF_RVTM);
  constexpr unsigned KDELTA = (256 / KCH) * QLD * 2, VDELTA = (256 / VCH) * 2048 * 2, VMDELTA = (256 / VCH) * 16 * 2;
  const int key0 = tid / KCH, kc0 = tid % KCH, d0 = tid / VCH, vc0 = tid % VCH;
  const unsigned kb0 = KOFF + (unsigned)(((b * 2048 + key0) * QLD + h * DK + kc0 * 8) * 2);
  const unsigned km0 = KOFF + (unsigned)(((MSEQ + key0 - PADK) * QLD + h * DK + kc0 * 8) * 2);
  const unsigned vb0 = VOFF + (unsigned)((((b * NH + h) * DV + d0) * 2048 + vc0 * 8) * 2);
  const unsigned vm0 = VMOFF + (unsigned)(((h * DV + d0) * 16 + (vc0 - PADK / 8) * 8) * 2);
  auto issue = [&](int jt, auto sc) {
    constexpr int S = decltype(sc)::value;
    if (jt == 0) {
#pragma unroll
      for (int ps = 0; ps < C::NKL; ++ps) {
        uint4 v = make_uint4(0u, 0u, 0u, 0u);
        if (key0 + ps * (256 / KCH) >= PADK) v = *(const uint4*)(wsb + (km0 + ps * KDELTA));
        pk[S][ps] = v;
      }
#pragma unroll
      for (int ps = 0; ps < C::NVL; ++ps) {
        uint4 v = make_uint4(0u, 0u, 0u, 0u);
        if (vc0 >= PADK / 8) v = *(const uint4*)(wsb + (vm0 + ps * VMDELTA));
        pv[S][ps] = v;
      }
    } else {
      const unsigned kt = kb0 + (unsigned)(jt - 1) * (TK * QLD * 2), vt = vb0 + (unsigned)(jt - 1) * (TK * 2);
#pragma unroll
      for (int ps = 0; ps < C::NKL; ++ps) pk[S][ps] = *(const uint4*)(wsb + (kt + ps * KDELTA));
#pragma unroll
      for (int ps = 0; ps < C::NVL; ++ps) pv[S][ps] = *(const uint4*)(wsb + (vt + ps * VDELTA));
    }
  };
  auto commit = [&](auto bc, auto sc) {
    constexpr int S = decltype(sc)::value;
    char* Ks = smem + decltype(bc)::value * C::STAGE; char* Vs = Ks + TK * KSTR;
#pragma unroll
    for (int ps = 0; ps < C::NKL; ++ps) { const int q = tid + 256 * ps, key = q / KCH, kc = q % KCH; *(uint4*)(Ks + key * KSTR + kc * 16) = pk[S][ps]; }
#pragma unroll
    for (int ps = 0; ps < C::NVL; ++ps) { const int q = tid + 256 * ps, d = q / VCH, kc = q % VCH; *(uint4*)(Vs + d * VSTR + kc * 16) = pv[S][ps]; }
  };
  if (NSET == 2) {
    issue(NT - 1, I0{}); if (NT > 1) issue(NT - 2, std::integral_constant<int, NSET - 1>{});
    commit(I0{}, I0{});
    if (NT > 2) issue(NT - 3, I0{});
  } else {
    issue(NT - 1, I0{}); commit(I0{}, I0{});
    if (NT > 1) issue(NT - 2, I0{});
  }
  __syncthreads();
  auto step = [&](int t, auto sc) {
    constexpr int S = decltype(sc)::value;
    typedef std::integral_constant<int, 1 - S> IN;
    const int jt = NT - 1 - t;
    const char* Ks = smem + S * C::STAGE; const char* Vs = Ks + TK * KSTR;
    const int ek0 = TK * jt;
    if (ek0 <= eq0 + 31) {
      const bool need_mask = (ek0 + TK - 1 > eq0);
      const int eq = eq0 + l32;
      if (FOX) {
        f32x16 st[2];
#pragma unroll
        for (int kb = 0; kb < 2; ++kb) {
#pragma unroll
          for (int s = 0; s < 2; ++s) {
            const float* cp = c2 + ek0 + 32 * kb + 16 * s + 8 * hl;
            const f32x4 ca = *(const f32x4*)cp, cb = *(const f32x4*)(cp + 4);
#pragma unroll
            for (int j = 0; j < 4; ++j) { st[kb][8 * s + j] = ca[j]; st[kb][8 * s + 4 + j] = cb[j]; }
          }
          const char* kp = Ks + (kb * 32 + prow) * KSTR + hl * 16;
#pragma unroll
          for (int ks = 0; ks < NKS; ++ks) { const bf16x8 a = *(const bf16x8*)(kp + ks * 32); st[kb] = MFMA32(a, qf[ks], st[kb]); }
        }
        if (need_mask) {
#pragma unroll
          for (int kb = 0; kb < 2; ++kb)
#pragma unroll
            for (int i = 0; i < 16; ++i) { const int ek = ek0 + 32 * kb + 16 * (i >> 3) + 8 * hl + (i & 7); if (ek > eq) st[kb][i] = -BIG; }
        }
        float mx = -BIG;
#pragma unroll
        for (int kb = 0; kb < 2; ++kb)
#pragma unroll
          for (int i = 0; i < 16; i += 2) mx = fmaxf(fmaxf(mx, st[kb][i]), st[kb][i + 1]);
        mx = xhalf_max(mx);
        const float mnew = fmaxf(mrun, mx);
        if (__any(mnew != mrun)) {
          const float alpha = __builtin_amdgcn_exp2f(mrun - mnew);
          mrun = mnew;
          lrun *= alpha;
#pragma unroll
          for (int mb = 0; mb < NMB; ++mb)
#pragma unroll
            for (int i = 0; i < 16; ++i) O[mb][i] *= alpha;
        }
        f32x2 ps2 = {0.f, 0.f};
        const f32x2 m2 = {mnew, mnew};
#pragma unroll
        for (int kb = 0; kb < 2; ++kb)
#pragma unroll
          for (int i = 0; i < 16; i += 2) {
            f32x2 t = {st[kb][i], st[kb][i + 1]};
            t = t - m2;
            t[0] = __builtin_amdgcn_exp2f(t[0]); t[1] = __builtin_amdgcn_exp2f(t[1]);
            ps2 = ps2 + t;
            st[kb][i] = t[0]; st[kb][i + 1] = t[1];
          }
        lrun += ps2[0] + ps2[1];
        bf16x8 pf[2][2];
#pragma unroll
        for (int kb = 0; kb < 2; ++kb)
#pragma unroll
          for (int s = 0; s < 2; ++s) {
            uint4 u;
            u.x = pack2(st[kb][8 * s + 0], st[kb][8 * s + 1]); u.y = pack2(st[kb][8 * s + 2], st[kb][8 * s + 3]);
            u.z = pack2(st[kb][8 * s + 4], st[kb][8 * s + 5]); u.w = pack2(st[kb][8 * s + 6], st[kb][8 * s + 7]);
            pf[kb][s] = __builtin_bit_cast(bf16x8, u);
          }
#pragma unroll
        for (int mb = 0; mb < NMB; ++mb) {
          const char* vp = Vs + (mb * 32 + l32) * VSTR + hl * 16;
#pragma unroll
          for (int kb = 0; kb < 2; ++kb)
#pragma unroll
            for (int s = 0; s < 2; ++s) { const bf16x8 a = *(const bf16x8*)(vp + kb * 64 + s * 32); O[mb] = MFMA32(a, pf[kb][s], O[mb]); }
        }
      } else {
        f32x16 st = zero16(), st1 = zero16();
        const char* kp = Ks + prow * KSTR + hl * 16;
#pragma unroll
        for (int ks = 0; ks < NKS; ks += 2) {
          const bf16x8 a = *(const bf16x8*)(kp + ks * 32), a1 = *(const bf16x8*)(kp + (ks + 1) * 32);
          st = MFMA32(a, qf[ks], st); st1 = MFMA32(a1, qf[ks + 1], st1);
        }
#pragma unroll
        for (int i = 0; i < 16; ++i) st[i] += st1[i];
        if (need_mask) {
#pragma unroll
          for (int i = 0; i < 16; ++i) { const int ek = ek0 + 16 * (i >> 3) + 8 * hl + (i & 7); if (ek > eq) st[i] = 0.f; }
        }
        bf16x8 pf[2];
#pragma unroll
        for (int s = 0; s < 2; ++s) {
          uint4 u;
          u.x = pack2(st[8 * s + 0], st[8 * s + 1]); u.y = pack2(st[8 * s + 2], st[8 * s + 3]);
          u.z = pack2(st[8 * s + 4], st[8 * s + 5]); u.w = pack2(st[8 * s + 6], st[8 * s + 7]);
          pf[s] = __builtin_bit_cast(bf16x8, u);
        }
#pragma unroll
        for (int mb = 0; mb < NMB; ++mb) {
          const char* vp = Vs + (dh * 128 + mb * 32 + l32) * VSTR + hl * 16;
#pragma unroll
          for (int s = 0; s < 2; ++s) { const bf16x8 a = *(const bf16x8*)(vp + s * 32); O[mb] = MFMA32(a, pf[s], O[mb]); }
        }
      }
    }
    if (t + 1 < NT) {
      typedef std::integral_constant<int, NSET == 2 ? 1 - S : 0> RS;
      commit(IN{}, RS{}); if (t + 1 + NSET < NT) issue(jt - 1 - NSET, RS{});
    }
    __syncthreads();
  };
  for (int t = 0; t < NT; t += 2) {
    step(t, I0{});
    if (t + 1 < NT) step(t + 1, I1{});
  }

  float scale;
  if (FOX) {
    const float lt = xhalf_sum(lrun);
    scale = 1.f / lt;
  } else {
    float ss = 0.f;
#pragma unroll
    for (int mb = 0; mb < NMB; ++mb)
#pragma unroll
      for (int i = 0; i < 16; ++i) ss += O[mb][i] * O[mb][i];
    ss = xhalf_sum(ss);
    if (hl == 0) c2[wave * 32 + l32] = ss;
    __syncthreads();
    ss += c2[(wave ^ 2) * 32 + l32];
    __syncthreads();
    scale = rsqrtf(ss * (1.f / DV) + EPS);
  }
  {
    char* img = smem + C::STAGE + wave * 4608;
    const int qrow0 = b * 2048 + qi * QPB + qg * 32;
#pragma unroll
    for (int rnd = 0; rnd < NMB / 2; ++rnd) {
#pragma unroll
      for (int mbl = 0; mbl < 2; ++mbl)
#pragma unroll
        for (int g = 0; g < 4; ++g) {
          const int mb = 2 * rnd + mbl;
          uint2 o; o.x = pack2(O[mb][4 * g] * scale, O[mb][4 * g + 1] * scale); o.y = pack2(O[mb][4 * g + 2] * scale, O[mb][4 * g + 3] * scale);
          *(uint2*)(img + l32 * 144 + (mbl * 32 + 8 * g + 4 * hl) * 2) = o;
        }
#pragma unroll
      for (int j = 0; j < 4; ++j) {
        const int q = lane + 64 * j, row = q >> 3, ch = q & 7;
        const uint4 y = *(const uint4*)(img + row * 144 + ch * 16);
        uint4* gptr = (uint4*)(Gg + (size_t)(qrow0 + row) * 1024 + h * DV + dh * 128 + rnd * 64 + ch * 8);
        const uint4 gv = *gptr;
        uint4 o;
        o.x = pack2(bflo(y.x) * bflo(gv.x), bfhi(y.x) * bfhi(gv.x)); o.y = pack2(bflo(y.y) * bflo(gv.y), bfhi(y.y) * bfhi(gv.y));
        o.z = pack2(bflo(y.z) * bflo(gv.z), bfhi(y.z) * bfhi(gv.z)); o.w = pack2(bflo(y.w) * bflo(gv.w), bfhi(y.w) * bfhi(gv.w));
        *gptr = o;
      }
    }
  }
}

template <bool FOX>
DI void mixer_pair(const Params& p, char* smem, int b, int h, int qa) {
  typedef MixCfg<FOX> C;
  const int tid = threadIdx.x, lane = tid & 63, wave = tid >> 6;
  float* c2 = (float*)(smem + 2 * C::STAGE);
  float* tot = c2 + 2112; float* pre = tot + 64;
  __syncthreads();
  if (FOX) {
    const int n_e = 64 + 128 * (qa + 1);
    const float* LF = (const float*)(p.ws + OFF_LF) + (size_t)(b * 16 + h) * 2048;
    const float* LFM = (const float*)(p.ws + OFF_LFM) + h * 16;
    {
      float raw[9];
#pragma unroll
      for (int k = 0; k < 9; ++k) { const int e = tid + 256 * k; raw[k] = (e >= 48 && e < n_e) ? (e < 64 ? LFM[e - 48] : LF[e - 64]) : 0.f; }
#pragma unroll
      for (int k = 0; k < 9; ++k) { const int e = tid + 256 * k; if (e < n_e) c2[e] = raw[k]; }
    }
    __syncthreads();
    for (int ch = wave; ch * 64 < n_e; ch += 4) {
      const int e = ch * 64 + lane;
      float v = c2[e];
#pragma unroll
      for (int o = 1; o < 64; o <<= 1) { const float t = __shfl_up(v, o); if (lane >= o) v += t; }
      c2[e] = v;
      if (lane == 63) tot[ch] = v;
    }
    __syncthreads();
    if (wave == 0) {
      const int nch = n_e >> 6;
      const float t0 = lane < nch ? tot[lane] : 0.f;
      float v = t0;
#pragma unroll
      for (int o = 1; o < 64; o <<= 1) { const float t = __shfl_up(v, o); if (lane >= o) v += t; }
      pre[lane] = v - t0;
    }
    __syncthreads();
    for (int e = tid; e < n_e; e += 256) c2[e] = e < 48 ? -BIG : -(c2[e] + pre[e >> 6]);
    __syncthreads();
  }
  constexpr int NQ = FOX ? 16 : 32;
  const int flip = blockIdx.x >= (gridDim.x >> 1) ? 1 : 0;
#pragma unroll 1
  for (int s = 0; s < 2; ++s) mixer_sub<FOX>(p, smem, b, h, (s ^ flip) ? NQ - 1 - qa : qa);
}

DI void phase_mixers(const Params& p, char* smem) {
  const int xcd = blockIdx.x & 7, loc = blockIdx.x >> 3, nloc = gridDim.x >> 3;
  for (int i = loc; i < 64; i += nloc) mixer_pair<false>(p, smem, xcd, i >> 4, 31 - (i & 15));
  for (int i = loc; i < 128; i += nloc) mixer_pair<true>(p, smem, xcd, i >> 3, 15 - (i & 7));
}

#define XB_TMO      128
#define XB_XCNT(j)  (256  + 64 * (j))
#define XB_XSUB(j)  (1280 + 64 * (j))
#define XB_XGEN(j)  (2304 + 64 * (j))
#define XB_TOP      3328
#define XB_TOPGEN   3392
#define XCD_BAR_WORDS 3456
#define XB_SPIN_CAP (1u << 22)
DI unsigned xb_ld(unsigned* p) { return __hip_atomic_load(p, __ATOMIC_RELAXED, __HIP_MEMORY_SCOPE_AGENT); }
DI unsigned xb_add(unsigned* p, unsigned v) { return __hip_atomic_fetch_add(p, v, __ATOMIC_RELAXED, __HIP_MEMORY_SCOPE_AGENT); }
DI unsigned xb_xcc_id() { return (unsigned)__builtin_amdgcn_s_getreg((3 << 11) | 20) & 0xFu; }
#define XB_SPIN(cond, bar) do { unsigned _sp = 0; while (cond) { __builtin_amdgcn_s_sleep(1); \
    if ((++_sp & 255u) == 0u) { if (xb_ld(&(bar)[XB_TMO])) break; if (_sp > XB_SPIN_CAP) { atomicAdd(&(bar)[XB_TMO], 1u); break; } } } } while (0)
struct XcdBarrier { unsigned* bar; unsigned x; volatile unsigned* st; };
DI XcdBarrier xcd_barrier_post(unsigned* bar, volatile unsigned* st) {
  XcdBarrier b; b.bar = bar; b.x = xb_xcc_id(); b.st = st;
  if (threadIdx.x == 0) (void)xb_add(&bar[XB_XCNT(b.x)], 1u);
  return b;
}
DI void xcd_barrier_complete(unsigned* bar, unsigned x, unsigned& nloc, unsigned& nx) {
  const unsigned G = gridDim.x;
  unsigned sum, cnt, mine, sp = 0u;
  for (;;) {
    sum = 0u; cnt = 0u; mine = 0u;
#pragma unroll
    for (unsigned j = 0; j < 16; ++j) { const unsigned c = xb_ld(&bar[XB_XCNT(j)]); sum += c; cnt += (c > 0u) ? 1u : 0u; mine = (j == x) ? c : mine; }
    if (sum == G) break;
    __builtin_amdgcn_s_sleep(1);
    if ((++sp & 255u) == 0u) { if (xb_ld(&bar[XB_TMO])) break; if (sp > XB_SPIN_CAP) { atomicAdd(&bar[XB_TMO], 1u); break; } }
  }
  nloc = mine > 0u ? mine : 1u; nx = cnt > 0u ? cnt : 1u;
}
DI void xcd_barrier(const XcdBarrier& b) {
  asm volatile("s_waitcnt vmcnt(0)" ::: "memory");
  __syncthreads();
  if (threadIdx.x == 0) {
    unsigned* bar = b.bar;
    __builtin_amdgcn_s_waitcnt(0);
    unsigned nloc = b.st[0], nx = b.st[1];
    if (nloc == 0u) { xcd_barrier_complete(bar, b.x, nloc, nx); b.st[0] = nloc; b.st[1] = nx; }
    const unsigned old = xb_add(&bar[XB_XSUB(b.x)], 1u);
    const unsigned gen = old / nloc;
    if (old + 1u == (gen + 1u) * nloc) {
      __builtin_amdgcn_fence(__ATOMIC_RELEASE, "agent");
      asm volatile("s_waitcnt vmcnt(0)" ::: "memory");
      const unsigned og = xb_add(&bar[XB_TOP], 1u);
      const unsigned tg = og / nx;
      if (og + 1u == (tg + 1u) * nx) xb_add(&bar[XB_TOPGEN], 1u);
      else XB_SPIN(xb_ld(&bar[XB_TOPGEN]) == tg, bar);
      __builtin_amdgcn_fence(__ATOMIC_ACQUIRE, "agent");
      xb_add(&bar[XB_XGEN(b.x)], 1u);
      asm volatile("s_waitcnt vmcnt(0)" ::: "memory");
    } else {
      XB_SPIN(xb_ld(&bar[XB_XGEN(b.x)]) == gen, bar);
      __builtin_amdgcn_fence(__ATOMIC_ACQUIRE, "agent");
      asm volatile("s_waitcnt vmcnt(0)" ::: "memory");
    }
  }
  __syncthreads();
}

__global__ void __launch_bounds__(256, 2) hymba_fwd(Params p) {
  __shared__ __attribute__((aligned(16))) char smem[SMEM_BYTES];
  __shared__ uint4 xb_words;
  if (threadIdx.x == 0) xb_words = make_uint4(0u, 0u, 0u, 0u);
  __syncthreads();
  const XcdBarrier xb = xcd_barrier_post((unsigned*)(p.ws + OFF_XB), (volatile unsigned*)&xb_words);
  if (p.ws == nullptr) cg::this_grid().sync();
  phase_prep(p, smem);
  xcd_barrier(xb);
  thin_tasks(p);
  gemm_phase<false>(p, smem);
  xcd_barrier(xb);
  phase_mixers(p, smem);
  xcd_barrier(xb);
  gemm_phase<true>(p, smem);
}

extern "C" void kernel_launch(void* const* d_in, const int* in_sizes, int n_in, void* d_out, int out_size, void* d_ws, size_t ws_size, hipStream_t stream) {
  static int grid_blocks = 0;
  if (!grid_blocks) {
    int dev = 0, cus = 0, per_cu = 0;
    hipGetDevice(&dev);
    hipDeviceGetAttribute(&cus, hipDeviceAttributeMultiprocessorCount, dev);
    hipOccupancyMaxActiveBlocksPerMultiprocessor(&per_cu, hymba_fwd, 256, 0);
    if (per_cu > 2) per_cu = 2;
    if (per_cu < 1) per_cu = 1;
    grid_blocks = cus * per_cu;
    grid_blocks &= ~7;
    if (ws_size < WS_END) fprintf(stderr, "workspace too small: %zu < %zu\n", ws_size, (size_t)WS_END);
  }
  Params p{};
  p.x = (const float*)d_in[0]; p.meta = (const float*)d_in[1]; p.norm_g = (const float*)d_in[2]; p.w_in = (const float*)d_in[3];
  p.b_f = (const float*)d_in[4]; p.w_out = (const float*)d_in[5]; p.final_g = (const float*)d_in[6];
  p.out = (float*)d_out; p.ws = (unsigned char*)d_ws;
  hipMemsetAsync((char*)d_ws + OFF_CTR, 0, (OFF_XB - OFF_CTR) + XCD_BAR_WORDS * 4, stream);
  void* args[] = {&p};
  hipError_t e = hipLaunchCooperativeKernel((void*)hymba_fwd, dim3(grid_blocks), dim3(256), args, 0, stream);
  if (e != hipSuccess) fprintf(stderr, "cooperative launch failed: %s (grid %d)\n", hipGetErrorString(e), grid_blocks);
}
```

```cpp
#include <hip/hip_runtime.h>
#include <hip/hip_cooperative_groups.h>
#include <stdint.h>
#include <stdio.h>
#include <type_traits>
namespace cg = cooperative_groups;

typedef __attribute__((ext_vector_type(8))) short bf16x8;
typedef __attribute__((ext_vector_type(16))) float f32x16;
typedef __attribute__((ext_vector_type(4))) float f32x4;
typedef __attribute__((ext_vector_type(2))) float f32x2;
typedef __attribute__((ext_vector_type(2))) __bf16 bf2_t;
typedef unsigned short bf16_t;
#define LOG2E_F 1.4426950408889634f

#define DI __device__ __forceinline__

constexpr int BATCH = 8, SEQ = 2048, DM = 1024, NMETA = 16, LTOK = 2064;
constexpr int MSEQ = BATCH * SEQ;
constexpr int MROWS = MSEQ + NMETA;
constexpr int NIN = 7184;
constexpr int NMAIN = 7168;
constexpr float EPS = 1e-6f;
constexpr float LOG2E = 1.4426950408889634f;
constexpr float QSCALE = 0.125f * LOG2E;
constexpr float DKS = 0.08838834764831845f;
constexpr float BIG = 1e30f;
constexpr int PCENTER = 1032;

constexpr size_t al256(size_t x) { return (x + 255) & ~(size_t)255; }
constexpr size_t OFF_RQ = 0;
constexpr size_t OFF_RK = al256(OFF_RQ + (size_t)MSEQ * 512 * 2);
constexpr size_t OFF_RVT = al256(OFF_RK + (size_t)MROWS * 512 * 2);
constexpr size_t OFF_RVTM = al256(OFF_RVT + (size_t)BATCH * 4 * 256 * 2048 * 2);
constexpr size_t OFF_RG = al256(OFF_RVTM + (size_t)4 * 256 * 16 * 2);
constexpr size_t OFF_FQ = al256(OFF_RG + (size_t)MSEQ * 1024 * 2);
constexpr size_t OFF_FK = al256(OFF_FQ + (size_t)MSEQ * 1024 * 2);
constexpr size_t OFF_FVT = al256(OFF_FK + (size_t)MROWS * 1024 * 2);
constexpr size_t OFF_FVTM = al256(OFF_FVT + (size_t)BATCH * 16 * 64 * 2048 * 2);
constexpr size_t OFF_FG = al256(OFF_FVTM + (size_t)16 * 64 * 16 * 2);
constexpr size_t OFF_LF = al256(OFF_FG + (size_t)MSEQ * 1024 * 2);
constexpr size_t OFF_LFM = al256(OFF_LF + (size_t)BATCH * 16 * 2048 * 4);
constexpr size_t OFF_WOT = al256(OFF_LFM + 16 * 16 * 4);
constexpr size_t OFF_COS = al256(OFF_WOT + (size_t)1024 * 2048 * 2);
constexpr size_t OFF_SIN = al256(OFF_COS + (size_t)LTOK * 64 * 4);
constexpr size_t OFF_CTR = al256(OFF_SIN + (size_t)LTOK * 64 * 4);
constexpr size_t OFF_XB = al256(OFF_CTR + 1024);
constexpr size_t OFF_EXCH = al256(OFF_XB + 16384);
constexpr size_t WS_END = OFF_EXCH + (size_t)64 * 8 * 256 * 4;
constexpr size_t OUT_U = 0;
constexpr size_t OUT_WINT = al256((size_t)MROWS * 1024 * 2);
static_assert(OUT_WINT + (size_t)NIN * 1024 * 2 <= (size_t)MSEQ * 1024 * 4, "d_out scratch overflow");
static_assert(WS_END <= (size_t)256 * 1024 * 1024, "workspace overflow");

constexpr int SMEM_BYTES = 73728 + 1024;

struct Params {
  const float* x; const float* meta; const float* norm_g; const float* w_in; const float* b_f; const float* w_out; const float* final_g;
  float* out; unsigned char* ws;
};

DI unsigned pack2(float a, float b) { f32x2 v = {a, b}; bf2_t r = __builtin_convertvector(v, bf2_t); return __builtin_bit_cast(unsigned, r); }
DI bf16_t f2bf(float a) { return (bf16_t)(pack2(a, 0.f) & 0xffffu); }
DI float bflo(unsigned u) { return __uint_as_float(u << 16); }
DI float bfhi(unsigned u) { return __uint_as_float(u & 0xffff0000u); }
DI float silu(float v) { return v * __builtin_amdgcn_rcpf(1.f + __builtin_amdgcn_exp2f(-LOG2E_F * v)); }
DI float wave_sum(float v) {
#pragma unroll
  for (int o = 32; o > 0; o >>= 1) v += __shfl_xor(v, o);
  return v;
}
DI f32x16 zero16() { f32x16 z;
#pragma unroll
  for (int i = 0; i < 16; ++i) z[i] = 0.f; return z; }
#define MFMA32(a, b, c) __builtin_amdgcn_mfma_f32_32x32x16_bf16((a), (b), (c), 0, 0, 0)
#define MFMA16(a, b, c) __builtin_amdgcn_mfma_f32_16x16x32_bf16((a), (b), (c), 0, 0, 0)
DI float xhalf_max(float v) { const unsigned u = __float_as_uint(v); auto r = __builtin_amdgcn_permlane32_swap(u, u, false, false); return fmaxf(__uint_as_float(r[0]), __uint_as_float(r[1])); }
DI float xhalf_sum(float v) { const unsigned u = __float_as_uint(v); auto r = __builtin_amdgcn_permlane32_swap(u, u, false, false); return __uint_as_float(r[0]) + __uint_as_float(r[1]); }
DI float lg2gamma(int h) { return log2f(1.f - exp2f(-5.f - (float)h)); }

DI void transpose_to_bf16(const float* __restrict__ src, bf16_t* __restrict__ dst, int K, int N, float* tile  ) {
  const int tid = threadIdx.x;
  const int kts = K / 64, nts = (N + 63) / 64, ntile = kts * nts;
  const int r0 = tid >> 4, c4 = tid & 15;
  float4 v[4];
  auto load = [&](int t) {
    const int kt = t % kts, nt = t / kts;
    const int n = nt * 64 + c4 * 4;
#pragma unroll
    for (int ps = 0; ps < 4; ++ps) {
      v[ps] = make_float4(0.f, 0.f, 0.f, 0.f);
      if (n < N) { const f32x4 t_ = __builtin_nontemporal_load((const f32x4*)(src + (size_t)(kt * 64 + r0 + 16 * ps) * N + n)); v[ps] = make_float4(t_[0], t_[1], t_[2], t_[3]); }
    }
  };
  int t = blockIdx.x;
  if (t < ntile) load(t);
  for (; t < ntile; t += gridDim.x) {
    const int kt = t % kts, nt = t / kts;
#pragma unroll
    for (int ps = 0; ps < 4; ++ps) {
      float* tp = tile + (r0 + 16 * ps) * 65 + c4 * 4;
      tp[0] = v[ps].x; tp[1] = v[ps].y; tp[2] = v[ps].z; tp[3] = v[ps].w;
    }
    if (t + (int)gridDim.x < ntile) load(t + gridDim.x);
    __syncthreads();
#pragma unroll
    for (int ps = 0; ps < 2; ++ps) {
      const int nr = (tid >> 3) + 32 * ps, kc = tid & 7;
      const int n = nt * 64 + nr;
      if (n < N) {
        const float* tp = tile + (kc * 8) * 65 + nr;
        uint4 o;
        o.x = pack2(tp[0 * 65], tp[1 * 65]); o.y = pack2(tp[2 * 65], tp[3 * 65]);
        o.z = pack2(tp[4 * 65], tp[5 * 65]); o.w = pack2(tp[6 * 65], tp[7 * 65]);
        *(uint4*)(dst + (size_t)n * K + kt * 64 + kc * 8) = o;
      }
    }
    __syncthreads();
  }
}

DI void phase_prep(const Params& p, char* smem) {
  const int tid = threadIdx.x, lane = tid & 63, wave = tid >> 6;
  const int gw = blockIdx.x * 4 + wave, nw = gridDim.x * 4;
  bf16_t* U = (bf16_t*)((char*)p.out + OUT_U);
  {
    float4 v[4], nx[4];
    int r = gw;
    if (r < MROWS) {
      const float* src = r < MSEQ ? p.x + (size_t)r * DM : p.meta + (size_t)(r - MSEQ) * DM;
#pragma unroll
      for (int q = 0; q < 4; ++q) { const f32x4 t_ = __builtin_nontemporal_load((const f32x4*)src + q * 64 + lane); v[q] = make_float4(t_[0], t_[1], t_[2], t_[3]); }
    }
    float4 g[4];
#pragma unroll
    for (int q = 0; q < 4; ++q) g[q] = ((const float4*)p.norm_g)[q * 64 + lane];
    for (; r < MROWS; r += nw) {
      const int rn = r + nw;
      if (rn < MROWS) {
        const float* src = rn < MSEQ ? p.x + (size_t)rn * DM : p.meta + (size_t)(rn - MSEQ) * DM;
#pragma unroll
        for (int q = 0; q < 4; ++q) { const f32x4 t_ = __builtin_nontemporal_load((const f32x4*)src + q * 64 + lane); nx[q] = make_float4(t_[0], t_[1], t_[2], t_[3]); }
      }
      float ss = 0.f;
#pragma unroll
      for (int q = 0; q < 4; ++q) ss += v[q].x * v[q].x + v[q].y * v[q].y + v[q].z * v[q].z + v[q].w * v[q].w;
      ss = wave_sum(ss);
      const float rstd = rsqrtf(ss * (1.f / DM) + EPS);
#pragma unroll
      for (int q = 0; q < 4; ++q) {
        uint2 o; o.x = pack2(v[q].x * rstd * g[q].x, v[q].y * rstd * g[q].y); o.y = pack2(v[q].z * rstd * g[q].z, v[q].w * rstd * g[q].w);
        *(uint2*)(U + (size_t)r * DM + (q * 64 + lane) * 4) = o;
      }
#pragma unroll
      for (int q = 0; q < 4; ++q) v[q] = nx[q];
    }
  }
  transpose_to_bf16(p.w_in, (bf16_t*)((char*)p.out + OUT_WINT), DM, NIN, (float*)smem);
  transpose_to_bf16(p.w_out, (bf16_t*)(p.ws + OFF_WOT), 2048, DM, (float*)smem);
  const int gt = blockIdx.x * 256 + tid, nt = gridDim.x * 256;
  float* ct = (float*)(p.ws + OFF_COS); float* st = (float*)(p.ws + OFF_SIN);
  for (int i = gt; i < LTOK * 64; i += nt) {
    const int l = i >> 6, j = i & 63;
    const float inv = (float)exp(-(double)j * (1.0 / 64.0) * 9.210340371976184);
    const float ang = (float)l * inv;
    double t = (double)ang * 0.15915494309189535; t -= rint(t);
    ct[i] = __builtin_amdgcn_cosf((float)t); st[i] = __builtin_amdgcn_sinf((float)t);
  }
}

DI float log_sigmoid(float v) { return v >= 0.f ? -log1pf(expf(-v)) : v - log1pf(expf(v)); }

DI void thin_tasks(const Params& p) {
  const int tid = threadIdx.x, lane = tid & 63, wave = tid >> 6;
  const int gw = blockIdx.x * 4 + wave, nw = gridDim.x * 4;
  const bf16_t* U = (const bf16_t*)((const char*)p.out + OUT_U);
  const bf16_t* WT = (const bf16_t*)((const char*)p.out + OUT_WINT);
  const int l16 = lane & 15, q4 = lane >> 4;
  for (int task = gw; task < 1025 + 112; task += nw) {
    if (task < 1025) {
      const int r0 = task * 16;
      const bf16_t* ap = U + (size_t)(r0 + l16) * DM + q4 * 8;
      const bf16_t* bp = WT + (size_t)(NMAIN + l16) * DM + q4 * 8;
      f32x4 acc = {0.f, 0.f, 0.f, 0.f};
#pragma unroll 8
      for (int ks = 0; ks < 32; ++ks) {
        const bf16x8 a = *(const bf16x8*)(ap + ks * 32), b = *(const bf16x8*)(bp + ks * 32);
        acc = MFMA16(a, b, acc);
      }
      const float bias = p.b_f[l16];
      float4 o;
      o.x = log_sigmoid(acc[0] + bias) * LOG2E; o.y = log_sigmoid(acc[1] + bias) * LOG2E;
      o.z = log_sigmoid(acc[2] + bias) * LOG2E; o.w = log_sigmoid(acc[3] + bias) * LOG2E;
      if (task < 1024) {
        const int b = r0 >> 11, s = (r0 & 2047) + q4 * 4;
        *(float4*)((float*)(p.ws + OFF_LF) + (size_t)(b * 16 + l16) * 2048 + s) = o;
      } else {
        *(float4*)((float*)(p.ws + OFF_LFM) + l16 * 16 + q4 * 4) = o;
      }
    } else {
      const int mtk = task - 1025, tl = mtk >> 2, pr = mtk & 3;
      const int nt = tl < 4 ? 4 + tl : tl < 12 ? 8 + (tl - 4) : tl < 20 ? 32 + (tl - 12) : 40 + (tl - 20);
      const int jA = 16 * pr + l16;
      const bf16_t* ap = U + (size_t)(MSEQ + l16) * DM + q4 * 8;
      const bf16_t* bp0 = WT + (size_t)(nt * 128 + jA) * DM + q4 * 8;
      const bf16_t* bp1 = bp0 + (size_t)64 * DM;
      f32x4 a0 = {0.f, 0.f, 0.f, 0.f}, a1 = {0.f, 0.f, 0.f, 0.f};
#pragma unroll 4
      for (int ks = 0; ks < 32; ++ks) {
        const bf16x8 a = *(const bf16x8*)(ap + ks * 32);
        const bf16x8 b0 = *(const bf16x8*)(bp0 + ks * 32), b1 = *(const bf16x8*)(bp1 + ks * 32);
        a0 = MFMA16(a, b0, a0); a1 = MFMA16(a, b1, a1);
      }
      const int m0 = q4 * 4;
      if (nt < 8) {
        const int h = nt - 4; const float lg = lg2gamma(h);
        bf16_t* RK = (bf16_t*)(p.ws + OFF_RK);
        const float* ct = (const float*)(p.ws + OFF_COS); const float* sn = (const float*)(p.ws + OFF_SIN);
#pragma unroll
        for (int i = 0; i < 4; ++i) {
          const int m = m0 + i;
          const float c = ct[m * 64 + jA], s = sn[m * 64 + jA];
          const float sc = DKS * exp2f(-(float)(m - PCENTER) * lg);
          bf16_t* d = RK + (size_t)(MSEQ + m) * 512 + h * 128 + jA;
          d[0] = f2bf((a0[i] * c - a1[i] * s) * sc); d[64] = f2bf((a0[i] * s + a1[i] * c) * sc);
        }
      } else if (nt < 16) {
        const int c0 = (nt - 8) * 128 + jA, c1 = c0 + 64;
        bf16_t* V = (bf16_t*)(p.ws + OFF_RVTM);
        uint2 o; o.x = pack2(a0[0], a0[1]); o.y = pack2(a0[2], a0[3]);
        *(uint2*)(V + (size_t)c0 * 16 + m0) = o;
        o.x = pack2(a1[0], a1[1]); o.y = pack2(a1[2], a1[3]);
        *(uint2*)(V + (size_t)c1 * 16 + m0) = o;
      } else if (nt < 40) {
        bf16_t* FK = (bf16_t*)(p.ws + OFF_FK);
        const int c0 = (nt - 32) * 128 + jA;
#pragma unroll
        for (int i = 0; i < 4; ++i) { bf16_t* d = FK + (size_t)(MSEQ + m0 + i) * 1024 + c0; d[0] = f2bf(a0[i]); d[64] = f2bf(a1[i]); }
      } else {
        const int c0 = (nt - 40) * 128 + jA, c1 = c0 + 64;
        bf16_t* V = (bf16_t*)(p.ws + OFF_FVTM);
        uint2 o; o.x = pack2(a0[0], a0[1]); o.y = pack2(a0[2], a0[3]);
        *(uint2*)(V + (size_t)c0 * 16 + m0) = o;
        o.x = pack2(a1[0], a1[1]); o.y = pack2(a1[2], a1[3]);
        *(uint2*)(V + (size_t)c1 * 16 + m0) = o;
      }
    }
  }
}

constexpr int GS = 64;
constexpr int GA = 256 * GS, GB = 128 * GS;
constexpr int GSTAGE = GA + GB;

template <bool OUTP>
DI void gemm_phase(const Params& p, char* smem) {
  constexpr int KT = OUTP ? 64 : 32;
  constexpr int SNT = OUTP ? 1 : 7;
  constexpr int NSUP = 8 * SNT;
  constexpr int SPX = NSUP / 8;
  const int xcd = blockIdx.x & 7, loc = blockIdx.x >> 3, nloc = gridDim.x >> 3;
  const int tid = threadIdx.x, lane = tid & 63, wave = tid >> 6;
  const int l32 = lane & 31, hl = lane >> 5;
  const int wm = wave >> 1, wn = wave & 1;
  const bf16_t* Ab0; const bf16_t* Ab1; const bf16_t* Bb; int ldb;
  if (OUTP) { Ab0 = (const bf16_t*)(p.ws + OFF_RG); Ab1 = (const bf16_t*)(p.ws + OFF_FG); Bb = (const bf16_t*)(p.ws + OFF_WOT); ldb = 2048; }
  else { Ab0 = Ab1 = (const bf16_t*)((const char*)p.out + OUT_U); Bb = (const bf16_t*)((const char*)p.out + OUT_WINT); ldb = 1024; }
  float* ssl = (float*)(smem + 3 * GSTAGE);

  unsigned aoff[4], boff[2];
  auto set_tile = [&](int i) {
    const int s = xcd * SPX + (i >> 6), in = i & 63;
    const int mt_ = (s / SNT) * 8 + (in >> 3), nt_ = (s % SNT) * 8 + (in & 7);
    const int r16 = lane >> 2, pc = lane & 3;
#pragma unroll
    for (int j = 0; j < 4; ++j) { const int row = (wave * 4 + j) * 16 + r16; aoff[j] = (unsigned)(((mt_ * 256 + row) * 1024 + (pc ^ ((row >> 2) & 3)) * 8) * 2); }
#pragma unroll
    for (int j = 0; j < 2; ++j) { const int row = (wave * 2 + j) * 16 + r16; boff[j] = (unsigned)(((nt_ * 128 + row) * ldb + (pc ^ ((row >> 2) & 3)) * 8) * 2); }
  };
  auto dma = [&](int kt, int stg) {
    const int k0 = kt * 32;
    const char* Ak = (const char*)(OUTP ? (k0 < 1024 ? Ab0 : Ab1) : Ab0) + (OUTP ? (k0 & 1023) : k0) * 2;
    const char* Bk = (const char*)Bb + k0 * 2;
    char* As = smem + stg * GSTAGE + wave * 4096 + lane * 16; char* Bs = smem + stg * GSTAGE + GA + wave * 2048 + lane * 16;
#pragma unroll
    for (int j = 0; j < 4; ++j)
      __builtin_amdgcn_global_load_lds((const unsigned*)(Ak + aoff[j]), (__attribute__((address_space(3))) unsigned*)(As + j * 1024), 16, 0, 0);
#pragma unroll
    for (int j = 0; j < 2; ++j)
      __builtin_amdgcn_global_load_lds((const unsigned*)(Bk + boff[j]), (__attribute__((address_space(3))) unsigned*)(Bs + j * 1024), 16, 0, 0);
  };
  const int fsw = (l32 >> 2) & 3;
  const int cof0 = ((0 + hl) ^ fsw) * 16, cof1 = ((2 + hl) ^ fsw) * 16;

  __syncthreads();
  int ti = loc;
  if (!OUTP && ti < SPX * 64) { set_tile(ti); dma(0, 0); dma(1, 1); }
#pragma unroll 1
  for (; ti < SPX * 64; ti += nloc) {
  if (OUTP) { set_tile(ti); dma(0, 0); dma(1, 1); }
  const int s_ = xcd * SPX + (ti >> 6), in_ = ti & 63;
  const int mt = (s_ / SNT) * 8 + (in_ >> 3), nt = (s_ % SNT) * 8 + (in_ & 7);
  const int m0 = mt * 256, n0 = nt * 128;
  if (OUTP) ssl[tid] = 0.f;

  f32x16 acc[4][2];
#pragma unroll
  for (int a = 0; a < 4; ++a)
#pragma unroll
    for (int b = 0; b < 2; ++b) acc[a][b] = zero16();

  typedef __attribute__((ext_vector_type(4))) unsigned u32x4_t;
  const unsigned lds_base = (unsigned)(size_t)smem;
  const unsigned a_rd = lds_base + (unsigned)((wm * 128 + l32) * GS), b_rd = lds_base + (unsigned)(GA + (wn * 32 + l32) * GS);
  u32x4_t a0, a1, a2, a3, b0, b1, c0, c1, c2, c3, d0, d1;
  auto issue_reads = [&](int stg) {
    const unsigned so = (unsigned)(stg * GSTAGE);
    const unsigned aa0 = a_rd + so + cof0, bb0 = b_rd + so + cof0, aa1 = a_rd + so + cof1, bb1 = b_rd + so + cof1;
    asm volatile(
        "ds_read_b128 %0, %12\n\t"
        "ds_read_b128 %1, %12 offset:2048\n\t"
        "ds_read_b128 %2, %12 offset:4096\n\t"
        "ds_read_b128 %3, %12 offset:6144\n\t"
        "ds_read_b128 %4, %13\n\t"
        "ds_read_b128 %5, %13 offset:4096\n\t"
        "ds_read_b128 %6, %14\n\t"
        "ds_read_b128 %7, %14 offset:2048\n\t"
        "ds_read_b128 %8, %14 offset:4096\n\t"
        "ds_read_b128 %9, %14 offset:6144\n\t"
        "ds_read_b128 %10, %15\n\t"
        "ds_read_b128 %11, %15 offset:4096"
        : "=&v"(a0), "=&v"(a1), "=&v"(a2), "=&v"(a3), "=&v"(b0), "=&v"(b1), "=&v"(c0), "=&v"(c1), "=&v"(c2), "=&v"(c3), "=&v"(d0), "=&v"(d1)
        : "v"(aa0), "v"(bb0), "v"(aa1), "v"(bb1)
        : "memory");
  };
  auto mfmas = [&]() {
#define BF(x) __builtin_bit_cast(bf16x8, x)
    asm volatile("s_waitcnt lgkmcnt(6)" : "+v"(a0), "+v"(a1), "+v"(a2), "+v"(a3), "+v"(b0), "+v"(b1), "+v"(c0), "+v"(c1), "+v"(c2), "+v"(c3), "+v"(d0), "+v"(d1) :: "memory");
    acc[0][0] = MFMA32(BF(a0), BF(b0), acc[0][0]); acc[0][1] = MFMA32(BF(a0), BF(b1), acc[0][1]);
    acc[1][0] = MFMA32(BF(a1), BF(b0), acc[1][0]); acc[1][1] = MFMA32(BF(a1), BF(b1), acc[1][1]);
    acc[2][0] = MFMA32(BF(a2), BF(b0), acc[2][0]); acc[2][1] = MFMA32(BF(a2), BF(b1), acc[2][1]);
    acc[3][0] = MFMA32(BF(a3), BF(b0), acc[3][0]); acc[3][1] = MFMA32(BF(a3), BF(b1), acc[3][1]);
    asm volatile("s_waitcnt lgkmcnt(0)" : "+v"(c0), "+v"(c1), "+v"(c2), "+v"(c3), "+v"(d0), "+v"(d1) :: "memory");
    acc[0][0] = MFMA32(BF(c0), BF(d0), acc[0][0]); acc[0][1] = MFMA32(BF(c0), BF(d1), acc[0][1]);
    acc[1][0] = MFMA32(BF(c1), BF(d0), acc[1][0]); acc[1][1] = MFMA32(BF(c1), BF(d1), acc[1][1]);
    acc[2][0] = MFMA32(BF(c2), BF(d0), acc[2][0]); acc[2][1] = MFMA32(BF(c2), BF(d1), acc[2][1]);
    acc[3][0] = MFMA32(BF(c3), BF(d0), acc[3][0]); acc[3][1] = MFMA32(BF(c3), BF(d1), acc[3][1]);
#undef BF
  };
  asm volatile("s_waitcnt vmcnt(0)" ::: "memory");
  __syncthreads();
  int stg = 0;
#pragma unroll 1
  for (int kt = 0; kt < KT; ++kt) {
    const bool more = kt + 2 < KT;
    issue_reads(stg);
    if (more) dma(kt + 2, stg == 0 ? 2 : stg - 1);
    mfmas();
    if (more) asm volatile("s_waitcnt vmcnt(6)" ::: "memory");
    else asm volatile("s_waitcnt vmcnt(0)" ::: "memory");
    __builtin_amdgcn_s_barrier();
    stg = stg == 2 ? 0 : stg + 1;
  }
  if (!OUTP && ti + nloc < SPX * 64) { set_tile(ti + nloc); dma(0, 0); dma(1, 1); }

  const int cl = wn * 32 + l32;
  if (OUTP) {
    const char* xb = (const char*)p.x; char* ob = (char*)p.out;
    const int rl0 = wm * 128 + 4 * hl;
    const unsigned off0 = (unsigned)(((m0 + rl0) * DM + n0 + cl) * 4);
    float* red = (float*)smem;
#pragma unroll
    for (int mi = 0; mi < 4; ++mi)
#pragma unroll
      for (int i = 0; i < 16; ++i) {
        const int dr = mi * 32 + 8 * (i >> 2) + (i & 3);
        const unsigned off = off0 + (unsigned)(dr * DM * 4);
        const float h0 = __builtin_nontemporal_load((const float*)(xb + off)) + acc[mi][0][i], h1 = __builtin_nontemporal_load((const float*)(xb + off + 256)) + acc[mi][1][i];
        acc[mi][0][i] = h0; acc[mi][1][i] = h1;
        red[(rl0 + dr) * 65 + cl] = h0 * h0 + h1 * h1;
        if ((i & 7) == 7) asm volatile("" ::: "memory");
      }
    __syncthreads();
    {
      float s = 0.f;
#pragma unroll 16
      for (int k = 0; k < 64; ++k) s += red[tid * 65 + k];
      ssl[tid] = s;
    }
    float* exch = (float*)(p.ws + OFF_EXCH) + (size_t)mt * 8 * 256;
    unsigned* flag = (unsigned*)(p.ws + OFF_CTR) + 64 + mt;
    __hip_atomic_store(exch + nt * 256 + tid, ssl[tid], __ATOMIC_RELAXED, __HIP_MEMORY_SCOPE_AGENT);
    asm volatile("s_waitcnt vmcnt(0)" ::: "memory");
    __syncthreads();
    if (tid == 0) {
      __hip_atomic_fetch_add(flag, 1u, __ATOMIC_RELAXED, __HIP_MEMORY_SCOPE_AGENT);
      while (__hip_atomic_load(flag, __ATOMIC_RELAXED, __HIP_MEMORY_SCOPE_AGENT) < 8u) __builtin_amdgcn_s_sleep(1);
    }
    __syncthreads();
    {
      float tot = 0.f;
#pragma unroll
      for (int c = 0; c < 8; ++c) tot += __hip_atomic_load(exch + c * 256 + tid, __ATOMIC_RELAXED, __HIP_MEMORY_SCOPE_AGENT);
      ssl[tid] = rsqrtf(tot * (1.f / DM) + EPS);
    }
    __syncthreads();
    const float g0 = p.final_g[n0 + cl], g1 = p.final_g[n0 + cl + 64];
#pragma unroll
    for (int mi = 0; mi < 4; ++mi)
#pragma unroll
      for (int i = 0; i < 16; ++i) {
        const int dr = mi * 32 + 8 * (i >> 2) + (i & 3);
        const unsigned off = off0 + (unsigned)(dr * DM * 4);
        const float rs = ssl[rl0 + dr];
        __builtin_nontemporal_store(acc[mi][0][i] * rs * g0, (float*)(ob + off)); __builtin_nontemporal_store(acc[mi][1][i] * rs * g1, (float*)(ob + off + 256));
      }
    __syncthreads();
  } else {
    if (nt < 8) {
      const int h = nt & 3; const float lg = lg2gamma(h);
      const bool isq = nt < 4;
      char* dbase = isq ? (char*)(p.ws + OFF_RQ) : (char*)(p.ws + OFF_RK);
      const float* ct = (const float*)(p.ws + OFF_COS); const float* sn = (const float*)(p.ws + OFF_SIN);
      const int rb = m0 + wm * 128 + 4 * hl;
      const unsigned off0 = (unsigned)((rb * 512 + h * 128 + cl) * 2);
      const float sgn = isq ? lg : -lg, mul = isq ? 1.f : DKS;
#pragma unroll
      for (int mi = 0; mi < 4; ++mi)
#pragma unroll
        for (int i = 0; i < 16; ++i) {
          const int dr = mi * 32 + 8 * (i >> 2) + (i & 3);
          const int pos = NMETA + ((rb + dr) & 2047);
          const float c = ct[pos * 64 + cl], s = sn[pos * 64 + cl];
          const float sc = mul * __builtin_amdgcn_exp2f((float)(pos - PCENTER) * sgn);
          const float x1 = acc[mi][0][i], x2 = acc[mi][1][i];
          const unsigned u = pack2((x1 * c - x2 * s) * sc, (x1 * s + x2 * c) * sc);
          char* d = dbase + (off0 + (unsigned)(dr * 1024));
          *(bf16_t*)d = (bf16_t)u; *(bf16_t*)(d + 128) = (bf16_t)(u >> 16);
          if ((i & 7) == 7) asm volatile("" ::: "memory");
        }
    } else if ((nt >= 8 && nt < 16) || (nt >= 40 && nt < 48)) {
      const bool isr = nt < 16;
      bf16_t* V = isr ? (bf16_t*)(p.ws + OFF_RVT) : (bf16_t*)(p.ws + OFF_FVT);
      const int b = m0 >> 11;
#pragma unroll
      for (int ni = 0; ni < 2; ++ni) {
        const int c = (isr ? (nt - 8) : (nt - 40)) * 128 + cl + 64 * ni;
        bf16_t* vrow = V + ((size_t)b * 1024 + c) * 2048 + (m0 & 2047);
#pragma unroll
        for (int mi = 0; mi < 4; ++mi) {
          uint2 o[4];
#pragma unroll
          for (int g = 0; g < 4; ++g) { o[g].x = pack2(acc[mi][ni][4 * g], acc[mi][ni][4 * g + 1]); o[g].y = pack2(acc[mi][ni][4 * g + 2], acc[mi][ni][4 * g + 3]); }
#pragma unroll
          for (int k = 0; k < 4; k += 2) {
            auto r0 = __builtin_amdgcn_permlane32_swap(o[k].x, o[k + 1].x, false, false);
            auto r1 = __builtin_amdgcn_permlane32_swap(o[k].y, o[k + 1].y, false, false);
            *(uint4*)(vrow + wm * 128 + mi * 32 + 8 * k + 8 * hl) = make_uint4(r0[0], r1[0], r0[1], r1[1]);
          }
        }
      }
    } else {
      char* dbase; int cb; int mode;
      if (nt < 24) { dbase = (char*)(p.ws + OFF_RG); cb = (nt - 16) * 128; mode = 0; }
      else if (nt < 32) { dbase = (char*)(p.ws + OFF_FQ); cb = (nt - 24) * 128; mode = 1; }
      else if (nt < 40) { dbase = (char*)(p.ws + OFF_FK); cb = (nt - 32) * 128; mode = 2; }
      else { dbase = (char*)(p.ws + OFF_FG); cb = (nt - 48) * 128; mode = 0; }
      const unsigned off0 = (unsigned)(((m0 + wm * 128 + 4 * hl) * 1024 + cb + cl) * 2);
#define ROWMAJOR_STORE(EXPR0, EXPR1) \
      _Pragma("unroll") for (int mi = 0; mi < 4; ++mi) \
      _Pragma("unroll") for (int i = 0; i < 16; ++i) { \
        const float a0 = acc[mi][0][i], a1 = acc[mi][1][i]; \
        const unsigned u = pack2(EXPR0, EXPR1); \
        char* d = dbase + (off0 + (unsigned)((mi * 32 + 8 * (i >> 2) + (i & 3)) * 2048)); \
        *(bf16_t*)d = (bf16_t)u; *(bf16_t*)(d + 128) = (bf16_t)(u >> 16); \
      }
      if (mode == 0) { ROWMAJOR_STORE(silu(a0), silu(a1)) }
      else if (mode == 1) { ROWMAJOR_STORE(a0 * QSCALE, a1 * QSCALE) }
      else { ROWMAJOR_STORE(a0, a1) }
#undef ROWMAJOR_STORE
    }
  }
  }
}

DI int kperm(int m) { return 16 * (m >> 4) + 8 * ((m >> 2) & 1) + 4 * ((m >> 3) & 1) + (m & 3); }

template <bool FOX>
struct MixCfg {
  static constexpr int DK = FOX ? 64 : 128, DV = FOX ? 64 : 256, NH = FOX ? 16 : 4;
  static constexpr int TK = FOX ? 64 : 32;
  static constexpr int KSTR = (DK + 8) * 2, VSTR = TK * 2 + 16;
  static constexpr int NKS = DK / 16, NMB = FOX ? 2 : 4, KCH = DK / 8, VCH = TK / 8, NKB = TK / 32;
  static constexpr int QLD = FOX ? 1024 : 512;
  static constexpr int QPB = FOX ? 128 : 64;
  static constexpr int NKL = TK * KCH / 256, NVL = DV * VCH / 256;
  static constexpr int STAGE = TK * KSTR + DV * VSTR;
  static constexpr int PADK = TK - 16;
};

template <bool FOX>
DI void mixer_sub(const Params& p, char* smem, int b, int h, int qi) {
  typedef MixCfg<FOX> C;
  constexpr int DK = C::DK, DV = C::DV, NH = C::NH, TK = C::TK, KSTR = C::KSTR, VSTR = C::VSTR, NKS = C::NKS, NMB = C::NMB;
  constexpr int KCH = C::KCH, VCH = C::VCH, NKB = C::NKB, QLD = C::QLD, QPB = C::QPB, PADK = C::PADK;
  float* c2 = (float*)(smem + 2 * C::STAGE);
  const int tid = threadIdx.x, lane = tid & 63, wave = tid >> 6, l32 = lane & 31, hl = lane >> 5;
  const int qg = FOX ? wave : (wave & 1), dh = FOX ? 0 : (wave >> 1);
  const bf16_t* Qg = FOX ? (const bf16_t*)(p.ws + OFF_FQ) : (const bf16_t*)(p.ws + OFF_RQ);
  const bf16_t* Kg = FOX ? (const bf16_t*)(p.ws + OFF_FK) : (const bf16_t*)(p.ws + OFF_RK);
  const bf16_t* Vg = FOX ? (const bf16_t*)(p.ws + OFF_FVT) : (const bf16_t*)(p.ws + OFF_RVT);
  const bf16_t* Vm = FOX ? (const bf16_t*)(p.ws + OFF_FVTM) : (const bf16_t*)(p.ws + OFF_RVTM);
  bf16_t* Gg = FOX ? (bf16_t*)(p.ws + OFF_FG) : (bf16_t*)(p.ws + OFF_RG);

  const int eq0 = TK + qi * QPB + qg * 32;

  const int qrow = b * 2048 + qi * QPB + qg * 32 + l32;
  bf16x8 qf[NKS];
  {
    const bf16_t* qp = Qg + (size_t)qrow * QLD + h * DK + hl * 8;
#pragma unroll
    for (int ks = 0; ks < NKS; ++ks) qf[ks] = *(const bf16x8*)(qp + ks * 16);
  }
  f32x16 O[NMB];
#pragma unroll
  for (int mb = 0; mb < NMB; ++mb) O[mb] = zero16();
  float mrun = -BIG, lrun = 0.f;

  const int NT = 1 + QPB * (qi + 1) / TK;
  const int prow = kperm(l32);
  constexpr int NSET = FOX ? 2 : 1;
  uint4 pk[NSET][C::NKL], pv[NSET][C::NVL];
  typedef std::integral_constant<int, 0> I0; typedef std::integral_constant<int, 1> I1;
  const unsigned char* wsb = p.ws;
  constexpr unsigned KOFF = (unsigned)(FOX ? OFF_FK : OFF_RK), VOFF = (unsigned)(FOX ? OFF_FVT : OFF_RVT), VMOFF = (unsigned)(FOX ? OFF_FVTM : OFF_RVTM);
  constexpr unsigned KDELTA = (256 / KCH) * QLD * 2, VDELTA = (256 / VCH) * 2048 * 2, VMDELTA = (256 / VCH) * 16 * 2;
  const int key0 = tid / KCH, kc0 = tid % KCH, d0 = tid / VCH, vc0 = tid % VCH;
  const unsigned kb0 = KOFF + (unsigned)(((b * 2048 + key0) * QLD + h * DK + kc0 * 8) * 2);
  const unsigned km0 = KOFF + (unsigned)(((MSEQ + key0 - PADK) * QLD + h * DK + kc0 * 8) * 2);
  const unsigned vb0 = VOFF + (unsigned)((((b * NH + h) * DV + d0) * 2048 + vc0 * 8) * 2);
  const unsigned vm0 = VMOFF + (unsigned)(((h * DV + d0) * 16 + (vc0 - PADK / 8) * 8) * 2);
  auto issue = [&](int jt, auto sc) {
    constexpr int S = decltype(sc)::value;
    if (jt == 0) {
#pragma unroll
      for (int ps = 0; ps < C::NKL; ++ps) {
        uint4 v = make_uint4(0u, 0u, 0u, 0u);
        if (key0 + ps * (256 / KCH) >= PADK) v = *(const uint4*)(wsb + (km0 + ps * KDELTA));
        pk[S][ps] = v;
      }
#pragma unroll
      for (int ps = 0; ps < C::NVL; ++ps) {
        uint4 v = make_uint4(0u, 0u, 0u, 0u);
        if (vc0 >= PADK / 8) v = *(const uint4*)(wsb + (vm0 + ps * VMDELTA));
        pv[S][ps] = v;
      }
    } else {
      const unsigned kt = kb0 + (unsigned)(jt - 1) * (TK * QLD * 2), vt = vb0 + (unsigned)(jt - 1) * (TK * 2);
#pragma unroll
      for (int ps = 0; ps < C::NKL; ++ps) pk[S][ps] = *(const uint4*)(wsb + (kt + ps * KDELTA));
#pragma unroll
      for (int ps = 0; ps < C::NVL; ++ps) pv[S][ps] = *(const uint4*)(wsb + (vt + ps * VDELTA));
    }
  };
  auto commit = [&](auto bc, auto sc) {
    constexpr int S = decltype(sc)::value;
    char* Ks = smem + decltype(bc)::value * C::STAGE; char* Vs = Ks + TK * KSTR;
#pragma unroll
    for (int ps = 0; ps < C::NKL; ++ps) { const int q = tid + 256 * ps, key = q / KCH, kc = q % KCH; *(uint4*)(Ks + key * KSTR + kc * 16) = pk[S][ps]; }
#pragma unroll
    for (int ps = 0; ps < C::NVL; ++ps) { const int q = tid + 256 * ps, d = q / VCH, kc = q % VCH; *(uint4*)(Vs + d * VSTR + kc * 16) = pv[S][ps]; }
  };
  if (NSET == 2) {
    issue(NT - 1, I0{}); if (NT > 1) issue(NT - 2, std::integral_constant<int, NSET - 1>{});
    commit(I0{}, I0{});
    if (NT > 2) issue(NT - 3, I0{});
  } else {
    issue(NT - 1, I0{}); commit(I0{}, I0{});
    if (NT > 1) issue(NT - 2, I0{});
  }
  __syncthreads();
  auto step = [&](int t, auto sc) {
    constexpr int S = decltype(sc)::value;
    typedef std::integral_constant<int, 1 - S> IN;
    const int jt = NT - 1 - t;
    const char* Ks = smem + S * C::STAGE; const char* Vs = Ks + TK * KSTR;
    const int ek0 = TK * jt;
    if (ek0 <= eq0 + 31) {
      const bool need_mask = (ek0 + TK - 1 > eq0);
      const int eq = eq0 + l32;
      if (FOX) {
        f32x16 st[2];
#pragma unroll
        for (int kb = 0; kb < 2; ++kb) {
#pragma unroll
          for (int s = 0; s < 2; ++s) {
            const float* cp = c2 + ek0 + 32 * kb + 16 * s + 8 * hl;
            const f32x4 ca = *(const f32x4*)cp, cb = *(const f32x4*)(cp + 4);
#pragma unroll
            for (int j = 0; j < 4; ++j) { st[kb][8 * s + j] = ca[j]; st[kb][8 * s + 4 + j] = cb[j]; }
          }
          const char* kp = Ks + (kb * 32 + prow) * KSTR + hl * 16;
#pragma unroll
          for (int ks = 0; ks < NKS; ++ks) { const bf16x8 a = *(const bf16x8*)(kp + ks * 32); st[kb] = MFMA32(a, qf[ks], st[kb]); }
        }
        if (need_mask) {
#pragma unroll
          for (int kb = 0; kb < 2; ++kb)
#pragma unroll
            for (int i = 0; i < 16; ++i) { const int ek = ek0 + 32 * kb + 16 * (i >> 3) + 8 * hl + (i & 7); if (ek > eq) st[kb][i] = -BIG; }
        }
        float mx = -BIG;
#pragma unroll
        for (int kb = 0; kb < 2; ++kb)
#pragma unroll
          for (int i = 0; i < 16; i += 2) mx = fmaxf(fmaxf(mx, st[kb][i]), st[kb][i + 1]);
        mx = xhalf_max(mx);
        const float mnew = fmaxf(mrun, mx);
        if (__any(mnew != mrun)) {
          const float alpha = __builtin_amdgcn_exp2f(mrun - mnew);
          mrun = mnew;
          lrun *= alpha;
#pragma unroll
          for (int mb = 0; mb < NMB; ++mb)
#pragma unroll
            for (int i = 0; i < 16; ++i) O[mb][i] *= alpha;
        }
        f32x2 ps2 = {0.f, 0.f};
        const f32x2 m2 = {mnew, mnew};
#pragma unroll
        for (int kb = 0; kb < 2; ++kb)
#pragma unroll
          for (int i = 0; i < 16; i += 2) {
            f32x2 t = {st[kb][i], st[kb][i + 1]};
            t = t - m2;
            t[0] = __builtin_amdgcn_exp2f(t[0]); t[1] = __builtin_amdgcn_exp2f(t[1]);
            ps2 = ps2 + t;
            st[kb][i] = t[0]; st[kb][i + 1] = t[1];
          }
        lrun += ps2[0] + ps2[1];
        bf16x8 pf[2][2];
#pragma unroll
        for (int kb = 0; kb < 2; ++kb)
#pragma unroll
          for (int s = 0; s < 2; ++s) {
            uint4 u;
            u.x = pack2(st[kb][8 * s + 0], st[kb][8 * s + 1]); u.y = pack2(st[kb][8 * s + 2], st[kb][8 * s + 3]);
            u.z = pack2(st[kb][8 * s + 4], st[kb][8 * s + 5]); u.w = pack2(st[kb][8 * s + 6], st[kb][8 * s + 7]);
            pf[kb][s] = __builtin_bit_cast(bf16x8, u);
          }
#pragma unroll
        for (int mb = 0; mb < NMB; ++mb) {
          const char* vp = Vs + (mb * 32 + l32) * VSTR + hl * 16;
#pragma unroll
          for (int kb = 0; kb < 2; ++kb)
#pragma unroll
            for (int s = 0; s < 2; ++s) { const bf16x8 a = *(const bf16x8*)(vp + kb * 64 + s * 32); O[mb] = MFMA32(a, pf[kb][s], O[mb]); }
        }
      } else {
        f32x16 st = zero16(), st1 = zero16();
        const char* kp = Ks + prow * KSTR + hl * 16;
#pragma unroll
        for (int ks = 0; ks < NKS; ks += 2) {
          const bf16x8 a = *(const bf16x8*)(kp + ks * 32), a1 = *(const bf16x8*)(kp + (ks + 1) * 32);
          st = MFMA32(a, qf[ks], st); st1 = MFMA32(a1, qf[ks + 1], st1);
        }
#pragma unroll
        for (int i = 0; i < 16; ++i) st[i] += st1[i];
        if (need_mask) {
#pragma unroll
          for (int i = 0; i < 16; ++i) { const int ek = ek0 + 16 * (i >> 3) + 8 * hl + (i & 7); if (ek > eq) st[i] = 0.f; }
        }
        bf16x8 pf[2];
#pragma unroll
        for (int s = 0; s < 2; ++s) {
          uint4 u;
          u.x = pack2(st[8 * s + 0], st[8 * s + 1]); u.y = pack2(st[8 * s + 2], st[8 * s + 3]);
          u.z = pack2(st[8 * s + 4], st[8 * s + 5]); u.w = pack2(st[8 * s + 6], st[8 * s + 7]);
          pf[s] = __builtin_bit_cast(bf16x8, u);
        }
#pragma unroll
        for (int mb = 0; mb < NMB; ++mb) {
          const char* vp = Vs + (dh * 128 + mb * 32 + l32) * VSTR + hl * 16;
#pragma unroll
          for (int s = 0; s < 2; ++s) { const bf16x8 a = *(const bf16x8*)(vp + s * 32); O[mb] = MFMA32(a, pf[s], O[mb]); }
        }
      }
    }
    if (t + 1 < NT) {
      typedef std::integral_constant<int, NSET == 2 ? 1 - S : 0> RS;
      commit(IN{}, RS{}); if (t + 1 + NSET < NT) issue(jt - 1 - NSET, RS{});
    }
    __syncthreads();
  };
  for (int t = 0; t < NT; t += 2) {
    step(t, I0{});
    if (t + 1 < NT) step(t + 1, I1{});
  }

  float scale;
  if (FOX) {
    const float lt = xhalf_sum(lrun);
    scale = 1.f / lt;
  } else {
    float ss = 0.f;
#pragma unroll
    for (int mb = 0; mb < NMB; ++mb)
#pragma unroll
      for (int i = 0; i < 16; ++i) ss += O[mb][i] * O[mb][i];
    ss = xhalf_sum(ss);
    if (hl == 0) c2[wave * 32 + l32] = ss;
    __syncthreads();
    ss += c2[(wave ^ 2) * 32 + l32];
    __syncthreads();
    scale = rsqrtf(ss * (1.f / DV) + EPS);
  }
  bf16_t* gp = Gg + (size_t)qrow * 1024 + h * DV + dh * 128 + 8 * hl;
#pragma unroll
  for (int mb = 0; mb < NMB; ++mb)
#pragma unroll
    for (int k = 0; k < 4; k += 2) {
      uint4* a = (uint4*)(gp + mb * 32 + 8 * k);
      const uint4 L = *a;
      auto g0 = __builtin_amdgcn_permlane32_swap(L.x, L.z, false, false);
      auto g1 = __builtin_amdgcn_permlane32_swap(L.y, L.w, false, false);
      uint2 o0, o1;
      o0.x = pack2(O[mb][4 * k] * scale * bflo(g0[0]), O[mb][4 * k + 1] * scale * bfhi(g0[0]));
      o0.y = pack2(O[mb][4 * k + 2] * scale * bflo(g1[0]), O[mb][4 * k + 3] * scale * bfhi(g1[0]));
      o1.x = pack2(O[mb][4 * k + 4] * scale * bflo(g0[1]), O[mb][4 * k + 5] * scale * bfhi(g0[1]));
      o1.y = pack2(O[mb][4 * k + 6] * scale * bflo(g1[1]), O[mb][4 * k + 7] * scale * bfhi(g1[1]));
      auto r0 = __builtin_amdgcn_permlane32_swap(o0.x, o1.x, false, false);
      auto r1 = __builtin_amdgcn_permlane32_swap(o0.y, o1.y, false, false);
      *a = make_uint4(r0[0], r1[0], r0[1], r1[1]);
    }
}

template <bool FOX>
DI void mixer_pair(const Params& p, char* smem, int b, int h, int qa) {
  typedef MixCfg<FOX> C;
  const int tid = threadIdx.x, lane = tid & 63, wave = tid >> 6;
  float* c2 = (float*)(smem + 2 * C::STAGE);
  float* tot = c2 + 2112; float* pre = tot + 64;
  __syncthreads();
  if (FOX) {
    const int n_e = 64 + 128 * (qa + 1);
    const float* LF = (const float*)(p.ws + OFF_LF) + (size_t)(b * 16 + h) * 2048;
    const float* LFM = (const float*)(p.ws + OFF_LFM) + h * 16;
    {
      float raw[9];
#pragma unroll
      for (int k = 0; k < 9; ++k) { const int e = tid + 256 * k; raw[k] = (e >= 48 && e < n_e) ? (e < 64 ? LFM[e - 48] : LF[e - 64]) : 0.f; }
#pragma unroll
      for (int k = 0; k < 9; ++k) { const int e = tid + 256 * k; if (e < n_e) c2[e] = raw[k]; }
    }
    __syncthreads();
    for (int ch = wave; ch * 64 < n_e; ch += 4) {
      const int e = ch * 64 + lane;
      float v = c2[e];
#pragma unroll
      for (int o = 1; o < 64; o <<= 1) { const float t = __shfl_up(v, o); if (lane >= o) v += t; }
      c2[e] = v;
      if (lane == 63) tot[ch] = v;
    }
    __syncthreads();
    if (wave == 0) {
      const int nch = n_e >> 6;
      const float t0 = lane < nch ? tot[lane] : 0.f;
      float v = t0;
#pragma unroll
      for (int o = 1; o < 64; o <<= 1) { const float t = __shfl_up(v, o); if (lane >= o) v += t; }
      pre[lane] = v - t0;
    }
    __syncthreads();
    for (int e = tid; e < n_e; e += 256) c2[e] = e < 48 ? -BIG : -(c2[e] + pre[e >> 6]);
    __syncthreads();
  }
  constexpr int NQ = FOX ? 16 : 32;
  const int flip = blockIdx.x >= (gridDim.x >> 1) ? 1 : 0;
#pragma unroll 1
  for (int s = 0; s < 2; ++s) mixer_sub<FOX>(p, smem, b, h, (s ^ flip) ? NQ - 1 - qa : qa);
}

DI void phase_mixers(const Params& p, char* smem) {
  const int xcd = blockIdx.x & 7, loc = blockIdx.x >> 3, nloc = gridDim.x >> 3;
  for (int i = loc; i < 64; i += nloc) mixer_pair<false>(p, smem, xcd, i >> 4, 31 - (i & 15));
  for (int i = loc; i < 128; i += nloc) mixer_pair<true>(p, smem, xcd, i >> 3, 15 - (i & 7));
}

#define XB_TMO      128
#define XB_XCNT(j)  (256  + 64 * (j))
#define XB_XSUB(j)  (1280 + 64 * (j))
#define XB_XGEN(j)  (2304 + 64 * (j))
#define XB_TOP      3328
#define XB_TOPGEN   3392
#define XCD_BAR_WORDS 3456
#define XB_SPIN_CAP (1u << 22)
DI unsigned xb_ld(unsigned* p) { return __hip_atomic_load(p, __ATOMIC_RELAXED, __HIP_MEMORY_SCOPE_AGENT); }
DI unsigned xb_add(unsigned* p, unsigned v) { return __hip_atomic_fetch_add(p, v, __ATOMIC_RELAXED, __HIP_MEMORY_SCOPE_AGENT); }
DI unsigned xb_xcc_id() { return (unsigned)__builtin_amdgcn_s_getreg((3 << 11) | 20) & 0xFu; }
#define XB_SPIN(cond, bar) do { unsigned _sp = 0; while (cond) { __builtin_amdgcn_s_sleep(1); \
    if ((++_sp & 255u) == 0u) { if (xb_ld(&(bar)[XB_TMO])) break; if (_sp > XB_SPIN_CAP) { atomicAdd(&(bar)[XB_TMO], 1u); break; } } } } while (0)
struct XcdBarrier { unsigned* bar; unsigned x; volatile unsigned* st; };
DI XcdBarrier xcd_barrier_post(unsigned* bar, volatile unsigned* st) {
  XcdBarrier b; b.bar = bar; b.x = xb_xcc_id(); b.st = st;
  if (threadIdx.x == 0) (void)xb_add(&bar[XB_XCNT(b.x)], 1u);
  return b;
}
DI void xcd_barrier_complete(unsigned* bar, unsigned x, unsigned& nloc, unsigned& nx) {
  const unsigned G = gridDim.x;
  unsigned sum, cnt, mine, sp = 0u;
  for (;;) {
    sum = 0u; cnt = 0u; mine = 0u;
#pragma unroll
    for (unsigned j = 0; j < 16; ++j) { const unsigned c = xb_ld(&bar[XB_XCNT(j)]); sum += c; cnt += (c > 0u) ? 1u : 0u; mine = (j == x) ? c : mine; }
    if (sum == G) break;
    __builtin_amdgcn_s_sleep(1);
    if ((++sp & 255u) == 0u) { if (xb_ld(&bar[XB_TMO])) break; if (sp > XB_SPIN_CAP) { atomicAdd(&bar[XB_TMO], 1u); break; } }
  }
  nloc = mine > 0u ? mine : 1u; nx = cnt > 0u ? cnt : 1u;
}
DI void xcd_barrier(const XcdBarrier& b) {
  asm volatile("s_waitcnt vmcnt(0)" ::: "memory");
  __syncthreads();
  if (threadIdx.x == 0) {
    unsigned* bar = b.bar;
    __builtin_amdgcn_s_waitcnt(0);
    unsigned nloc = b.st[0], nx = b.st[1];
    if (nloc == 0u) { xcd_barrier_complete(bar, b.x, nloc, nx); b.st[0] = nloc; b.st[1] = nx; }
    const unsigned old = xb_add(&bar[XB_XSUB(b.x)], 1u);
    const unsigned gen = old / nloc;
    if (old + 1u == (gen + 1u) * nloc) {
      __builtin_amdgcn_fence(__ATOMIC_RELEASE, "agent");
      asm volatile("s_waitcnt vmcnt(0)" ::: "memory");
      const unsigned og = xb_add(&bar[XB_TOP], 1u);
      const unsigned tg = og / nx;
      if (og + 1u == (tg + 1u) * nx) xb_add(&bar[XB_TOPGEN], 1u);
      else XB_SPIN(xb_ld(&bar[XB_TOPGEN]) == tg, bar);
      __builtin_amdgcn_fence(__ATOMIC_ACQUIRE, "agent");
      xb_add(&bar[XB_XGEN(b.x)], 1u);
      asm volatile("s_waitcnt vmcnt(0)" ::: "memory");
    } else {
      XB_SPIN(xb_ld(&bar[XB_XGEN(b.x)]) == gen, bar);
      __builtin_amdgcn_fence(__ATOMIC_ACQUIRE, "agent");
      asm volatile("s_waitcnt vmcnt(0)" ::: "memory");
    }
  }
  __syncthreads();
}

__global__ void __launch_bounds__(256, 2) hymba_fwd(Params p) {
  __shared__ __attribute__((aligned(16))) char smem[SMEM_BYTES];
  __shared__ uint4 xb_words;
  if (threadIdx.x == 0) xb_words = make_uint4(0u, 0u, 0u, 0u);
  __syncthreads();
  const XcdBarrier xb = xcd_barrier_post((unsigned*)(p.ws + OFF_XB), (volatile unsigned*)&xb_words);
  if (p.ws == nullptr) cg::this_grid().sync();
  phase_prep(p, smem);
  xcd_barrier(xb);
  thin_tasks(p);
  gemm_phase<false>(p, smem);
  xcd_barrier(xb);
  phase_mixers(p, smem);
  xcd_barrier(xb);
  gemm_phase<true>(p, smem);
}

extern "C" void kernel_launch(void* const* d_in, const int* in_sizes, int n_in, void* d_out, int out_size, void* d_ws, size_t ws_size, hipStream_t stream) {
  static int grid_blocks = 0;
  if (!grid_blocks) {
    int dev = 0, cus = 0, per_cu = 0;
    hipGetDevice(&dev);
    hipDeviceGetAttribute(&cus, hipDeviceAttributeMultiprocessorCount, dev);
    hipOccupancyMaxActiveBlocksPerMultiprocessor(&per_cu, hymba_fwd, 256, 0);
    if (per_cu > 2) per_cu = 2;
    if (per_cu < 1) per_cu = 1;
    grid_blocks = cus * per_cu;
    grid_blocks &= ~7;
    if (ws_size < WS_END) fprintf(stderr, "workspace too small: %zu < %zu\n", ws_size, (size_t)WS_END);
  }
  Params p{};
  p.x = (const float*)d_in[0]; p.meta = (const float*)d_in[1]; p.norm_g = (const float*)d_in[2]; p.w_in = (const float*)d_in[3];
  p.b_f = (const float*)d_in[4]; p.w_out = (const float*)d_in[5]; p.final_g = (const float*)d_in[6];
  p.out = (float*)d_out; p.ws = (unsigned char*)d_ws;
  hipMemsetAsync((char*)d_ws + OFF_CTR, 0, (OFF_XB - OFF_CTR) + XCD_BAR_WORDS * 4, stream);
  void* args[] = {&p};
  hipError_t e = hipLaunchCooperativeKernel((void*)hymba_fwd, dim3(grid_blocks), dim3(256), args, 0, stream);
  if (e != hipSuccess) fprintf(stderr, "cooperative launch failed: %s (grid %d)\n", hipGetErrorString(e), grid_blocks);
}
```

```cpp
#include <hip/hip_runtime.h>
#include <hip/hip_cooperative_groups.h>
#include <stdint.h>
#include <stdio.h>
#include <type_traits>
namespace cg = cooperative_groups;

typedef __attribute__((ext_vector_type(8))) short bf16x8;
typedef __attribute__((ext_vector_type(16))) float f32x16;
typedef __attribute__((ext_vector_type(4))) float f32x4;
typedef __attribute__((ext_vector_type(2))) float f32x2;
typedef __attribute__((ext_vector_type(2))) __bf16 bf2_t;
typedef unsigned short bf16_t;
#define LOG2E_F 1.4426950408889634f

#define DI __device__ __forceinline__

constexpr int BATCH = 8, SEQ = 2048, DM = 1024, NMETA = 16, LTOK = 2064;
constexpr int MSEQ = BATCH * SEQ;
constexpr int MROWS = MSEQ + NMETA;
constexpr int NIN = 7184;
constexpr int NMAIN = 7168;
constexpr float EPS = 1e-6f;
constexpr float LOG2E = 1.4426950408889634f;
constexpr float QSCALE = 0.125f * LOG2E;
constexpr float DKS = 0.08838834764831845f;
constexpr float BIG = 1e30f;
constexpr int PCENTER = 1032;

constexpr size_t al256(size_t x) { return (x + 255) & ~(size_t)255; }
constexpr size_t OFF_RQ = 0;
constexpr size_t OFF_RK = al256(OFF_RQ + (size_t)MSEQ * 512 * 2);
constexpr size_t OFF_RVT = al256(OFF_RK + (size_t)MROWS * 512 * 2);
constexpr size_t OFF_RVTM = al256(OFF_RVT + (size_t)BATCH * 4 * 256 * 2048 * 2);
constexpr size_t OFF_RG = al256(OFF_RVTM + (size_t)4 * 256 * 16 * 2);
constexpr size_t OFF_FQ = al256(OFF_RG + (size_t)MSEQ * 1024 * 2);
constexpr size_t OFF_FK = al256(OFF_FQ + (size_t)MSEQ * 1024 * 2);
constexpr size_t OFF_FVT = al256(OFF_FK + (size_t)MROWS * 1024 * 2);
constexpr size_t OFF_FVTM = al256(OFF_FVT + (size_t)BATCH * 16 * 64 * 2048 * 2);
constexpr size_t OFF_FG = al256(OFF_FVTM + (size_t)16 * 64 * 16 * 2);
constexpr size_t OFF_LF = al256(OFF_FG + (size_t)MSEQ * 1024 * 2);
constexpr size_t OFF_LFM = al256(OFF_LF + (size_t)BATCH * 16 * 2048 * 4);
constexpr size_t OFF_WOT = al256(OFF_LFM + 16 * 16 * 4);
constexpr size_t OFF_COS = al256(OFF_WOT + (size_t)1024 * 2048 * 2);
constexpr size_t OFF_SIN = al256(OFF_COS + (size_t)LTOK * 64 * 4);
constexpr size_t OFF_CTR = al256(OFF_SIN + (size_t)LTOK * 64 * 4);
constexpr size_t OFF_XB = al256(OFF_CTR + 1024);
constexpr size_t OFF_EXCH = al256(OFF_XB + 16384);
constexpr size_t WS_END = OFF_EXCH + (size_t)64 * 8 * 256 * 4;
constexpr size_t OUT_U = 0;
constexpr size_t OUT_WINT = al256((size_t)MROWS * 1024 * 2);
static_assert(OUT_WINT + (size_t)NIN * 1024 * 2 <= (size_t)MSEQ * 1024 * 4, "d_out scratch overflow");
static_assert(WS_END <= (size_t)256 * 1024 * 1024, "workspace overflow");

constexpr int SMEM_BYTES = 73728 + 1024;

struct Params {
  const float* x; const float* meta; const float* norm_g; const float* w_in; const float* b_f; const float* w_out; const float* final_g;
  float* out; unsigned char* ws;
};

DI unsigned pack2(float a, float b) { f32x2 v = {a, b}; bf2_t r = __builtin_convertvector(v, bf2_t); return __builtin_bit_cast(unsigned, r); }
DI bf16_t f2bf(float a) { return (bf16_t)(pack2(a, 0.f) & 0xffffu); }
DI float bflo(unsigned u) { return __uint_as_float(u << 16); }
DI float bfhi(unsigned u) { return __uint_as_float(u & 0xffff0000u); }
DI float silu(float v) { return v * __builtin_amdgcn_rcpf(1.f + __builtin_amdgcn_exp2f(-LOG2E_F * v)); }
DI float wave_sum(float v) {
#pragma unroll
  for (int o = 32; o > 0; o >>= 1) v += __shfl_xor(v, o);
  return v;
}
DI f32x16 zero16() { f32x16 z;
#pragma unroll
  for (int i = 0; i < 16; ++i) z[i] = 0.f; return z; }
#define MFMA32(a, b, c) __builtin_amdgcn_mfma_f32_32x32x16_bf16((a), (b), (c), 0, 0, 0)
#define MFMA16(a, b, c) __builtin_amdgcn_mfma_f32_16x16x32_bf16((a), (b), (c), 0, 0, 0)
DI float xhalf_max(float v) { const unsigned u = __float_as_uint(v); auto r = __builtin_amdgcn_permlane32_swap(u, u, false, false); return fmaxf(__uint_as_float(r[0]), __uint_as_float(r[1])); }
DI float xhalf_sum(float v) { const unsigned u = __float_as_uint(v); auto r = __builtin_amdgcn_permlane32_swap(u, u, false, false); return __uint_as_float(r[0]) + __uint_as_float(r[1]); }
DI float wave_incl_scan(float x) {
  int v = __builtin_bit_cast(int, x);
#define DPP_ADD(CTRL, ROWM) v = __builtin_bit_cast(int, __builtin_bit_cast(float, v) + __builtin_bit_cast(float, __builtin_amdgcn_update_dpp(0, v, CTRL, ROWM, 0xf, false)))
  DPP_ADD(0x111, 0xf);
  DPP_ADD(0x112, 0xf);
  DPP_ADD(0x114, 0xf);
  DPP_ADD(0x118, 0xf);
  DPP_ADD(0x142, 0xa);
  DPP_ADD(0x143, 0xc);
#undef DPP_ADD
  return __builtin_bit_cast(float, v);
}
DI float lg2gamma(int h) { return log2f(1.f - exp2f(-5.f - (float)h)); }

DI void transpose_to_bf16(const float* __restrict__ src, bf16_t* __restrict__ dst, int K, int N, float* tile  ) {
  const int tid = threadIdx.x;
  const int kts = K / 64, nts = (N + 63) / 64, ntile = kts * nts;
  const int r0 = tid >> 4, c4 = tid & 15;
  float4 v[4];
  auto load = [&](int t) {
    const int kt = t % kts, nt = t / kts;
    const int n = nt * 64 + c4 * 4;
#pragma unroll
    for (int ps = 0; ps < 4; ++ps) {
      v[ps] = make_float4(0.f, 0.f, 0.f, 0.f);
      if (n < N) { const f32x4 t_ = __builtin_nontemporal_load((const f32x4*)(src + (size_t)(kt * 64 + r0 + 16 * ps) * N + n)); v[ps] = make_float4(t_[0], t_[1], t_[2], t_[3]); }
    }
  };
  int t = blockIdx.x;
  if (t < ntile) load(t);
  for (; t < ntile; t += gridDim.x) {
    const int kt = t % kts, nt = t / kts;
#pragma unroll
    for (int ps = 0; ps < 4; ++ps) {
      float* tp = tile + (r0 + 16 * ps) * 65 + c4 * 4;
      tp[0] = v[ps].x; tp[1] = v[ps].y; tp[2] = v[ps].z; tp[3] = v[ps].w;
    }
    if (t + (int)gridDim.x < ntile) load(t + gridDim.x);
    __syncthreads();
#pragma unroll
    for (int ps = 0; ps < 2; ++ps) {
      const int nr = (tid >> 3) + 32 * ps, kc = tid & 7;
      const int n = nt * 64 + nr;
      if (n < N) {
        const float* tp = tile + (kc * 8) * 65 + nr;
        uint4 o;
        o.x = pack2(tp[0 * 65], tp[1 * 65]); o.y = pack2(tp[2 * 65], tp[3 * 65]);
        o.z = pack2(tp[4 * 65], tp[5 * 65]); o.w = pack2(tp[6 * 65], tp[7 * 65]);
        *(uint4*)(dst + (size_t)n * K + kt * 64 + kc * 8) = o;
      }
    }
    __syncthreads();
  }
}

DI void phase_prep(const Params& p, char* smem) {
  const int tid = threadIdx.x, lane = tid & 63, wave = tid >> 6;
  const int gw = blockIdx.x * 4 + wave, nw = gridDim.x * 4;
  bf16_t* U = (bf16_t*)((char*)p.out + OUT_U);
  {
    float4 v[4], nx[4];
    int r = gw;
    if (r < MROWS) {
      const float* src = r < MSEQ ? p.x + (size_t)r * DM : p.meta + (size_t)(r - MSEQ) * DM;
#pragma unroll
      for (int q = 0; q < 4; ++q) { const f32x4 t_ = __builtin_nontemporal_load((const f32x4*)src + q * 64 + lane); v[q] = make_float4(t_[0], t_[1], t_[2], t_[3]); }
    }
    float4 g[4];
#pragma unroll
    for (int q = 0; q < 4; ++q) g[q] = ((const float4*)p.norm_g)[q * 64 + lane];
    for (; r < MROWS; r += nw) {
      const int rn = r + nw;
      if (rn < MROWS) {
        const float* src = rn < MSEQ ? p.x + (size_t)rn * DM : p.meta + (size_t)(rn - MSEQ) * DM;
#pragma unroll
        for (int q = 0; q < 4; ++q) { const f32x4 t_ = __builtin_nontemporal_load((const f32x4*)src + q * 64 + lane); nx[q] = make_float4(t_[0], t_[1], t_[2], t_[3]); }
      }
      float ss = 0.f;
#pragma unroll
      for (int q = 0; q < 4; ++q) ss += v[q].x * v[q].x + v[q].y * v[q].y + v[q].z * v[q].z + v[q].w * v[q].w;
      ss = wave_sum(ss);
      const float rstd = rsqrtf(ss * (1.f / DM) + EPS);
#pragma unroll
      for (int q = 0; q < 4; ++q) {
        uint2 o; o.x = pack2(v[q].x * rstd * g[q].x, v[q].y * rstd * g[q].y); o.y = pack2(v[q].z * rstd * g[q].z, v[q].w * rstd * g[q].w);
        *(uint2*)(U + (size_t)r * DM + (q * 64 + lane) * 4) = o;
      }
#pragma unroll
      for (int q = 0; q < 4; ++q) v[q] = nx[q];
    }
  }
  transpose_to_bf16(p.w_in, (bf16_t*)((char*)p.out + OUT_WINT), DM, NIN, (float*)smem);
  transpose_to_bf16(p.w_out, (bf16_t*)(p.ws + OFF_WOT), 2048, DM, (float*)smem);
  const int gt = blockIdx.x * 256 + tid, nt = gridDim.x * 256;
  float* ct = (float*)(p.ws + OFF_COS); float* st = (float*)(p.ws + OFF_SIN);
  for (int i = gt; i < LTOK * 64; i += nt) {
    const int l = i >> 6, j = i & 63;
    const float inv = (float)exp(-(double)j * (1.0 / 64.0) * 9.210340371976184);
    const float ang = (float)l * inv;
    double t = (double)ang * 0.15915494309189535; t -= rint(t);
    ct[i] = __builtin_amdgcn_cosf((float)t); st[i] = __builtin_amdgcn_sinf((float)t);
  }
}

DI float log_sigmoid(float v) { return v >= 0.f ? -log1pf(expf(-v)) : v - log1pf(expf(v)); }

DI void thin_tasks(const Params& p) {
  const int tid = threadIdx.x, lane = tid & 63, wave = tid >> 6;
  const int gw = blockIdx.x * 4 + wave, nw = gridDim.x * 4;
  const bf16_t* U = (const bf16_t*)((const char*)p.out + OUT_U);
  const bf16_t* WT = (const bf16_t*)((const char*)p.out + OUT_WINT);
  const int l16 = lane & 15, q4 = lane >> 4;
  for (int task = gw; task < 1025 + 112; task += nw) {
    if (task < 1025) {
      const int r0 = task * 16;
      const bf16_t* ap = U + (size_t)(r0 + l16) * DM + q4 * 8;
      const bf16_t* bp = WT + (size_t)(NMAIN + l16) * DM + q4 * 8;
      f32x4 acc = {0.f, 0.f, 0.f, 0.f};
#pragma unroll 8
      for (int ks = 0; ks < 32; ++ks) {
        const bf16x8 a = *(const bf16x8*)(ap + ks * 32), b = *(const bf16x8*)(bp + ks * 32);
        acc = MFMA16(a, b, acc);
      }
      const float bias = p.b_f[l16];
      float4 o;
      o.x = log_sigmoid(acc[0] + bias) * LOG2E; o.y = log_sigmoid(acc[1] + bias) * LOG2E;
      o.z = log_sigmoid(acc[2] + bias) * LOG2E; o.w = log_sigmoid(acc[3] + bias) * LOG2E;
      if (task < 1024) {
        const int b = r0 >> 11, s = (r0 & 2047) + q4 * 4;
        *(float4*)((float*)(p.ws + OFF_LF) + (size_t)(b * 16 + l16) * 2048 + s) = o;
      } else {
        *(float4*)((float*)(p.ws + OFF_LFM) + l16 * 16 + q4 * 4) = o;
      }
    } else {
      const int mtk = task - 1025, tl = mtk >> 2, pr = mtk & 3;
      const int nt = tl < 4 ? 4 + tl : tl < 12 ? 8 + (tl - 4) : tl < 20 ? 32 + (tl - 12) : 40 + (tl - 20);
      const int jA = 16 * pr + l16;
      const bf16_t* ap = U + (size_t)(MSEQ + l16) * DM + q4 * 8;
      const bf16_t* bp0 = WT + (size_t)(nt * 128 + jA) * DM + q4 * 8;
      const bf16_t* bp1 = bp0 + (size_t)64 * DM;
      f32x4 a0 = {0.f, 0.f, 0.f, 0.f}, a1 = {0.f, 0.f, 0.f, 0.f};
#pragma unroll 4
      for (int ks = 0; ks < 32; ++ks) {
        const bf16x8 a = *(const bf16x8*)(ap + ks * 32);
        const bf16x8 b0 = *(const bf16x8*)(bp0 + ks * 32), b1 = *(const bf16x8*)(bp1 + ks * 32);
        a0 = MFMA16(a, b0, a0); a1 = MFMA16(a, b1, a1);
      }
      const int m0 = q4 * 4;
      if (nt < 8) {
        const int h = nt - 4; const float lg = lg2gamma(h);
        bf16_t* RK = (bf16_t*)(p.ws + OFF_RK);
        const float* ct = (const float*)(p.ws + OFF_COS); const float* sn = (const float*)(p.ws + OFF_SIN);
#pragma unroll
        for (int i = 0; i < 4; ++i) {
          const int m = m0 + i;
          const float c = ct[m * 64 + jA], s = sn[m * 64 + jA];
          const float sc = DKS * exp2f(-(float)(m - PCENTER) * lg);
          bf16_t* d = RK + (size_t)(MSEQ + m) * 512 + h * 128 + jA;
          d[0] = f2bf((a0[i] * c - a1[i] * s) * sc); d[64] = f2bf((a0[i] * s + a1[i] * c) * sc);
        }
      } else if (nt < 16) {
        const int c0 = (nt - 8) * 128 + jA, c1 = c0 + 64;
        bf16_t* V = (bf16_t*)(p.ws + OFF_RVTM);
        uint2 o; o.x = pack2(a0[0], a0[1]); o.y = pack2(a0[2], a0[3]);
        *(uint2*)(V + (size_t)c0 * 16 + m0) = o;
        o.x = pack2(a1[0], a1[1]); o.y = pack2(a1[2], a1[3]);
        *(uint2*)(V + (size_t)c1 * 16 + m0) = o;
      } else if (nt < 40) {
        bf16_t* FK = (bf16_t*)(p.ws + OFF_FK);
        const int c0 = (nt - 32) * 128 + jA;
#pragma unroll
        for (int i = 0; i < 4; ++i) { bf16_t* d = FK + (size_t)(MSEQ + m0 + i) * 1024 + c0; d[0] = f2bf(a0[i]); d[64] = f2bf(a1[i]); }
      } else {
        const int c0 = (nt - 40) * 128 + jA, c1 = c0 + 64;
        bf16_t* V = (bf16_t*)(p.ws + OFF_FVTM);
        uint2 o; o.x = pack2(a0[0], a0[1]); o.y = pack2(a0[2], a0[3]);
        *(uint2*)(V + (size_t)c0 * 16 + m0) = o;
        o.x = pack2(a1[0], a1[1]); o.y = pack2(a1[2], a1[3]);
        *(uint2*)(V + (size_t)c1 * 16 + m0) = o;
      }
    }
  }
}

constexpr int GS = 64;
constexpr int GA = 256 * GS, GB = 128 * GS;
constexpr int GSTAGE = GA + GB;

template <bool OUTP>
DI void gemm_phase(const Params& p, char* smem) {
  constexpr int KT = OUTP ? 64 : 32;
  constexpr int SNT = OUTP ? 1 : 7;
  constexpr int NSUP = 8 * SNT;
  constexpr int SPX = NSUP / 8;
  const int xcd = blockIdx.x & 7, loc = blockIdx.x >> 3, nloc = gridDim.x >> 3;
  const int tid = threadIdx.x, lane = tid & 63, wave = tid >> 6;
  const int l32 = lane & 31, hl = lane >> 5;
  const int wm = wave >> 1, wn = wave & 1;
  const bf16_t* Ab0; const bf16_t* Ab1; const bf16_t* Bb; int ldb;
  if (OUTP) { Ab0 = (const bf16_t*)(p.ws + OFF_RG); Ab1 = (const bf16_t*)(p.ws + OFF_FG); Bb = (const bf16_t*)(p.ws + OFF_WOT); ldb = 2048; }
  else { Ab0 = Ab1 = (const bf16_t*)((const char*)p.out + OUT_U); Bb = (const bf16_t*)((const char*)p.out + OUT_WINT); ldb = 1024; }
  float* ssl = (float*)(smem + 3 * GSTAGE);

  unsigned aoff[4], boff[2];
  auto set_tile = [&](int i) {
    const int s = xcd * SPX + (i >> 6), in = i & 63;
    const int mt_ = (s / SNT) * 8 + (in >> 3), nt_ = (s % SNT) * 8 + (in & 7);
    const int r16 = lane >> 2, pc = lane & 3;
#pragma unroll
    for (int j = 0; j < 4; ++j) { const int row = (wave * 4 + j) * 16 + r16; aoff[j] = (unsigned)(((mt_ * 256 + row) * 1024 + (pc ^ ((row >> 2) & 3)) * 8) * 2); }
#pragma unroll
    for (int j = 0; j < 2; ++j) { const int row = (wave * 2 + j) * 16 + r16; boff[j] = (unsigned)(((nt_ * 128 + row) * ldb + (pc ^ ((row >> 2) & 3)) * 8) * 2); }
  };
  auto dma = [&](int kt, int stg) {
    const int k0 = kt * 32;
    const char* Ak = (const char*)(OUTP ? (k0 < 1024 ? Ab0 : Ab1) : Ab0) + (OUTP ? (k0 & 1023) : k0) * 2;
    const char* Bk = (const char*)Bb + k0 * 2;
    char* As = smem + stg * GSTAGE + wave * 4096 + lane * 16; char* Bs = smem + stg * GSTAGE + GA + wave * 2048 + lane * 16;
#pragma unroll
    for (int j = 0; j < 4; ++j)
      __builtin_amdgcn_global_load_lds((const unsigned*)(Ak + aoff[j]), (__attribute__((address_space(3))) unsigned*)(As + j * 1024), 16, 0, 0);
#pragma unroll
    for (int j = 0; j < 2; ++j)
      __builtin_amdgcn_global_load_lds((const unsigned*)(Bk + boff[j]), (__attribute__((address_space(3))) unsigned*)(Bs + j * 1024), 16, 0, 0);
  };
  const int fsw = (l32 >> 2) & 3;
  const int cof0 = ((0 + hl) ^ fsw) * 16, cof1 = ((2 + hl) ^ fsw) * 16;

  __syncthreads();
  int ti = loc;
  if (!OUTP && ti < SPX * 64) { set_tile(ti); dma(0, 0); dma(1, 1); }
#pragma unroll 1
  for (; ti < SPX * 64; ti += nloc) {
  if (OUTP) { set_tile(ti); dma(0, 0); dma(1, 1); }
  const int s_ = xcd * SPX + (ti >> 6), in_ = ti & 63;
  const int mt = (s_ / SNT) * 8 + (in_ >> 3), nt = (s_ % SNT) * 8 + (in_ & 7);
  const int m0 = mt * 256, n0 = nt * 128;
  if (OUTP) ssl[tid] = 0.f;

  f32x16 acc[4][2];
#pragma unroll
  for (int a = 0; a < 4; ++a)
#pragma unroll
    for (int b = 0; b < 2; ++b) acc[a][b] = zero16();

  typedef __attribute__((ext_vector_type(4))) unsigned u32x4_t;
  const unsigned lds_base = (unsigned)(size_t)smem;
  const unsigned a_rd = lds_base + (unsigned)((wm * 128 + l32) * GS), b_rd = lds_base + (unsigned)(GA + (wn * 32 + l32) * GS);
  u32x4_t a0, a1, a2, a3, b0, b1, c0, c1, c2, c3, d0, d1;
  auto issue_reads = [&](int stg) {
    const unsigned so = (unsigned)(stg * GSTAGE);
    const unsigned aa0 = a_rd + so + cof0, bb0 = b_rd + so + cof0, aa1 = a_rd + so + cof1, bb1 = b_rd + so + cof1;
    asm volatile(
        "ds_read_b128 %0, %12\n\t"
        "ds_read_b128 %1, %12 offset:2048\n\t"
        "ds_read_b128 %2, %12 offset:4096\n\t"
        "ds_read_b128 %3, %12 offset:6144\n\t"
        "ds_read_b128 %4, %13\n\t"
        "ds_read_b128 %5, %13 offset:4096\n\t"
        "ds_read_b128 %6, %14\n\t"
        "ds_read_b128 %7, %14 offset:2048\n\t"
        "ds_read_b128 %8, %14 offset:4096\n\t"
        "ds_read_b128 %9, %14 offset:6144\n\t"
        "ds_read_b128 %10, %15\n\t"
        "ds_read_b128 %11, %15 offset:4096"
        : "=&v"(a0), "=&v"(a1), "=&v"(a2), "=&v"(a3), "=&v"(b0), "=&v"(b1), "=&v"(c0), "=&v"(c1), "=&v"(c2), "=&v"(c3), "=&v"(d0), "=&v"(d1)
        : "v"(aa0), "v"(bb0), "v"(aa1), "v"(bb1)
        : "memory");
  };
  auto mfmas = [&]() {
#define BF(x) __builtin_bit_cast(bf16x8, x)
    asm volatile("s_waitcnt lgkmcnt(6)" : "+v"(a0), "+v"(a1), "+v"(a2), "+v"(a3), "+v"(b0), "+v"(b1), "+v"(c0), "+v"(c1), "+v"(c2), "+v"(c3), "+v"(d0), "+v"(d1) :: "memory");
    acc[0][0] = MFMA32(BF(a0), BF(b0), acc[0][0]); acc[0][1] = MFMA32(BF(a0), BF(b1), acc[0][1]);
    acc[1][0] = MFMA32(BF(a1), BF(b0), acc[1][0]); acc[1][1] = MFMA32(BF(a1), BF(b1), acc[1][1]);
    acc[2][0] = MFMA32(BF(a2), BF(b0), acc[2][0]); acc[2][1] = MFMA32(BF(a2), BF(b1), acc[2][1]);
    acc[3][0] = MFMA32(BF(a3), BF(b0), acc[3][0]); acc[3][1] = MFMA32(BF(a3), BF(b1), acc[3][1]);
    asm volatile("s_waitcnt lgkmcnt(0)" : "+v"(c0), "+v"(c1), "+v"(c2), "+v"(c3), "+v"(d0), "+v"(d1) :: "memory");
    acc[0][0] = MFMA32(BF(c0), BF(d0), acc[0][0]); acc[0][1] = MFMA32(BF(c0), BF(d1), acc[0][1]);
    acc[1][0] = MFMA32(BF(c1), BF(d0), acc[1][0]); acc[1][1] = MFMA32(BF(c1), BF(d1), acc[1][1]);
    acc[2][0] = MFMA32(BF(c2), BF(d0), acc[2][0]); acc[2][1] = MFMA32(BF(c2), BF(d1), acc[2][1]);
    acc[3][0] = MFMA32(BF(c3), BF(d0), acc[3][0]); acc[3][1] = MFMA32(BF(c3), BF(d1), acc[3][1]);
#undef BF
  };
  asm volatile("s_waitcnt vmcnt(0)" ::: "memory");
  __syncthreads();
  int stg = 0;
#pragma unroll 1
  for (int kt = 0; kt < KT; ++kt) {
    const bool more = kt + 2 < KT;
    issue_reads(stg);
    if (more) dma(kt + 2, stg == 0 ? 2 : stg - 1);
    mfmas();
    if (more) asm volatile("s_waitcnt vmcnt(6)" ::: "memory");
    else asm volatile("s_waitcnt vmcnt(0)" ::: "memory");
    __builtin_amdgcn_s_barrier();
    stg = stg == 2 ? 0 : stg + 1;
  }
  if (!OUTP && ti + nloc < SPX * 64) { set_tile(ti + nloc); dma(0, 0); dma(1, 1); }

  const int cl = wn * 32 + l32;
  if (OUTP) {
    const char* xb = (const char*)p.x; char* ob = (char*)p.out;
    const int rl0 = wm * 128 + 4 * hl;
    const unsigned off0 = (unsigned)(((m0 + rl0) * DM + n0 + cl) * 4);
    float* red = (float*)smem;
#pragma unroll
    for (int mi = 0; mi < 4; ++mi)
#pragma unroll
      for (int i = 0; i < 16; ++i) {
        const int dr = mi * 32 + 8 * (i >> 2) + (i & 3);
        const unsigned off = off0 + (unsigned)(dr * DM * 4);
        const float h0 = __builtin_nontemporal_load((const float*)(xb + off)) + acc[mi][0][i], h1 = __builtin_nontemporal_load((const float*)(xb + off + 256)) + acc[mi][1][i];
        acc[mi][0][i] = h0; acc[mi][1][i] = h1;
        red[(rl0 + dr) * 65 + cl] = h0 * h0 + h1 * h1;
        if ((i & 7) == 7) asm volatile("" ::: "memory");
      }
    __syncthreads();
    {
      float s = 0.f;
#pragma unroll 16
      for (int k = 0; k < 64; ++k) s += red[tid * 65 + k];
      ssl[tid] = s;
    }
    float* exch = (float*)(p.ws + OFF_EXCH) + (size_t)mt * 8 * 256;
    unsigned* flag = (unsigned*)(p.ws + OFF_CTR) + 64 + mt;
    __hip_atomic_store(exch + nt * 256 + tid, ssl[tid], __ATOMIC_RELAXED, __HIP_MEMORY_SCOPE_AGENT);
    asm volatile("s_waitcnt vmcnt(0)" ::: "memory");
    __syncthreads();
    if (tid == 0) {
      __hip_atomic_fetch_add(flag, 1u, __ATOMIC_RELAXED, __HIP_MEMORY_SCOPE_AGENT);
      while (__hip_atomic_load(flag, __ATOMIC_RELAXED, __HIP_MEMORY_SCOPE_AGENT) < 8u) __builtin_amdgcn_s_sleep(1);
    }
    __syncthreads();
    {
      float tot = 0.f;
#pragma unroll
      for (int c = 0; c < 8; ++c) tot += __hip_atomic_load(exch + c * 256 + tid, __ATOMIC_RELAXED, __HIP_MEMORY_SCOPE_AGENT);
      ssl[tid] = rsqrtf(tot * (1.f / DM) + EPS);
    }
    __syncthreads();
    const float g0 = p.final_g[n0 + cl], g1 = p.final_g[n0 + cl + 64];
#pragma unroll
    for (int mi = 0; mi < 4; ++mi)
#pragma unroll
      for (int i = 0; i < 16; ++i) {
        const int dr = mi * 32 + 8 * (i >> 2) + (i & 3);
        const unsigned off = off0 + (unsigned)(dr * DM * 4);
        const float rs = ssl[rl0 + dr];
        __builtin_nontemporal_store(acc[mi][0][i] * rs * g0, (float*)(ob + off)); __builtin_nontemporal_store(acc[mi][1][i] * rs * g1, (float*)(ob + off + 256));
      }
    __syncthreads();
  } else {
    if (nt < 8) {
      const int h = nt & 3; const float lg = lg2gamma(h);
      const bool isq = nt < 4;
      char* dbase = isq ? (char*)(p.ws + OFF_RQ) : (char*)(p.ws + OFF_RK);
      const float* ct = (const float*)(p.ws + OFF_COS); const float* sn = (const float*)(p.ws + OFF_SIN);
      const int rb = m0 + wm * 128 + 4 * hl;
      const unsigned off0 = (unsigned)((rb * 512 + h * 128 + cl) * 2);
      const float sgn = isq ? lg : -lg, mul = isq ? 1.f : DKS;
#pragma unroll
      for (int mi = 0; mi < 4; ++mi)
#pragma unroll
        for (int i = 0; i < 16; ++i) {
          const int dr = mi * 32 + 8 * (i >> 2) + (i & 3);
          const int pos = NMETA + ((rb + dr) & 2047);
          const float c = ct[pos * 64 + cl], s = sn[pos * 64 + cl];
          const float sc = mul * __builtin_amdgcn_exp2f((float)(pos - PCENTER) * sgn);
          const float x1 = acc[mi][0][i], x2 = acc[mi][1][i];
          const unsigned u = pack2((x1 * c - x2 * s) * sc, (x1 * s + x2 * c) * sc);
          char* d = dbase + (off0 + (unsigned)(dr * 1024));
          *(bf16_t*)d = (bf16_t)u; *(bf16_t*)(d + 128) = (bf16_t)(u >> 16);
          if ((i & 7) == 7) asm volatile("" ::: "memory");
        }
    } else if ((nt >= 8 && nt < 16) || (nt >= 40 && nt < 48)) {
      const bool isr = nt < 16;
      bf16_t* V = isr ? (bf16_t*)(p.ws + OFF_RVT) : (bf16_t*)(p.ws + OFF_FVT);
      const int b = m0 >> 11;
#pragma unroll
      for (int ni = 0; ni < 2; ++ni) {
        const int c = (isr ? (nt - 8) : (nt - 40)) * 128 + cl + 64 * ni;
        bf16_t* vrow = V + ((size_t)b * 1024 + c) * 2048 + (m0 & 2047);
#pragma unroll
        for (int mi = 0; mi < 4; ++mi) {
          uint2 o[4];
#pragma unroll
          for (int g = 0; g < 4; ++g) { o[g].x = pack2(acc[mi][ni][4 * g], acc[mi][ni][4 * g + 1]); o[g].y = pack2(acc[mi][ni][4 * g + 2], acc[mi][ni][4 * g + 3]); }
#pragma unroll
          for (int k = 0; k < 4; k += 2) {
            auto r0 = __builtin_amdgcn_permlane32_swap(o[k].x, o[k + 1].x, false, false);
            auto r1 = __builtin_amdgcn_permlane32_swap(o[k].y, o[k + 1].y, false, false);
            *(uint4*)(vrow + wm * 128 + mi * 32 + 8 * k + 8 * hl) = make_uint4(r0[0], r1[0], r0[1], r1[1]);
          }
        }
      }
    } else {
      char* dbase; int cb; int mode;
      if (nt < 24) { dbase = (char*)(p.ws + OFF_RG); cb = (nt - 16) * 128; mode = 0; }
      else if (nt < 32) { dbase = (char*)(p.ws + OFF_FQ); cb = (nt - 24) * 128; mode = 1; }
      else if (nt < 40) { dbase = (char*)(p.ws + OFF_FK); cb = (nt - 32) * 128; mode = 2; }
      else { dbase = (char*)(p.ws + OFF_FG); cb = (nt - 48) * 128; mode = 0; }
      const unsigned off0 = (unsigned)(((m0 + wm * 128 + 4 * hl) * 1024 + cb + cl) * 2);
#define ROWMAJOR_STORE(EXPR0, EXPR1) \
      _Pragma("unroll") for (int mi = 0; mi < 4; ++mi) \
      _Pragma("unroll") for (int i = 0; i < 16; ++i) { \
        const float a0 = acc[mi][0][i], a1 = acc[mi][1][i]; \
        const unsigned u = pack2(EXPR0, EXPR1); \
        char* d = dbase + (off0 + (unsigned)((mi * 32 + 8 * (i >> 2) + (i & 3)) * 2048)); \
        *(bf16_t*)d = (bf16_t)u; *(bf16_t*)(d + 128) = (bf16_t)(u >> 16); \
      }
      if (mode == 0) { ROWMAJOR_STORE(silu(a0), silu(a1)) }
      else if (mode == 1) { ROWMAJOR_STORE(a0 * QSCALE, a1 * QSCALE) }
      else { ROWMAJOR_STORE(a0, a1) }
#undef ROWMAJOR_STORE
    }
  }
  }
}

DI int kperm(int m) { return 16 * (m >> 4) + 8 * ((m >> 2) & 1) + 4 * ((m >> 3) & 1) + (m & 3); }

template <bool FOX>
struct MixCfg {
  static constexpr int DK = FOX ? 64 : 128, DV = FOX ? 64 : 256, NH = FOX ? 16 : 4;
  static constexpr int TK = FOX ? 64 : 32;
  static constexpr int KSTR = (DK + 8) * 2, VSTR = TK * 2 + 16;
  static constexpr int NKS = DK / 16, NMB = FOX ? 2 : 4, KCH = DK / 8, VCH = TK / 8, NKB = TK / 32;
  static constexpr int QLD = FOX ? 1024 : 512;
  static constexpr int QPB = FOX ? 128 : 64;
  static constexpr int NKL = TK * KCH / 256, NVL = DV * VCH / 256;
  static constexpr int STAGE = TK * KSTR + DV * VSTR;
  static constexpr int PADK = TK - 16;
};

template <bool FOX>
DI void mixer_sub(const Params& p, char* smem, int b, int h, int qi) {
  typedef MixCfg<FOX> C;
  constexpr int DK = C::DK, DV = C::DV, NH = C::NH, TK = C::TK, KSTR = C::KSTR, VSTR = C::VSTR, NKS = C::NKS, NMB = C::NMB;
  constexpr int KCH = C::KCH, VCH = C::VCH, NKB = C::NKB, QLD = C::QLD, QPB = C::QPB, PADK = C::PADK;
  float* c2 = (float*)(smem + 2 * C::STAGE);
  const int tid = threadIdx.x, lane = tid & 63, wave = tid >> 6, l32 = lane & 31, hl = lane >> 5;
  const int qg = FOX ? wave : (wave & 1), dh = FOX ? 0 : (wave >> 1);
  const bf16_t* Qg = FOX ? (const bf16_t*)(p.ws + OFF_FQ) : (const bf16_t*)(p.ws + OFF_RQ);
  const bf16_t* Kg = FOX ? (const bf16_t*)(p.ws + OFF_FK) : (const bf16_t*)(p.ws + OFF_RK);
  const bf16_t* Vg = FOX ? (const bf16_t*)(p.ws + OFF_FVT) : (const bf16_t*)(p.ws + OFF_RVT);
  const bf16_t* Vm = FOX ? (const bf16_t*)(p.ws + OFF_FVTM) : (const bf16_t*)(p.ws + OFF_RVTM);
  bf16_t* Gg = FOX ? (bf16_t*)(p.ws + OFF_FG) : (bf16_t*)(p.ws + OFF_RG);

  const int eq0 = TK + qi * QPB + qg * 32;

  const int qrow = b * 2048 + qi * QPB + qg * 32 + l32;
  bf16x8 qf[NKS];
  {
    const bf16_t* qp = Qg + (size_t)qrow * QLD + h * DK + hl * 8;
#pragma unroll
    for (int ks = 0; ks < NKS; ++ks) qf[ks] = *(const bf16x8*)(qp + ks * 16);
  }
  f32x16 O[NMB];
#pragma unroll
  for (int mb = 0; mb < NMB; ++mb) O[mb] = zero16();
  float mrun = -BIG, lrun = 0.f;

  const int NT = 1 + QPB * (qi + 1) / TK;
  const int prow = kperm(l32);
  constexpr int NSET = FOX ? 2 : 1;
  uint4 pk[NSET][C::NKL], pv[NSET][C::NVL];
  typedef std::integral_constant<int, 0> I0; typedef std::integral_constant<int, 1> I1;
  const unsigned char* wsb = p.ws;
  constexpr unsigned KOFF = (unsigned)(FOX ? OFF_FK : OFF_RK), VOFF = (unsigned)(FOX ? OFF_FVT : OFF_RVT), VMOFF = (unsigned)(FOX ? OFF_FVTM : OFF_RVTM);
  constexpr unsigned KDELTA = (256 / KCH) * QLD * 2, VDELTA = (256 / VCH) * 2048 * 2, VMDELTA = (256 / VCH) * 16 * 2;
  const int key0 = tid / KCH, kc0 = tid % KCH, d0 = tid / VCH, vc0 = tid % VCH;
  const unsigned kb0 = KOFF + (unsigned)(((b * 2048 + key0) * QLD + h * DK + kc0 * 8) * 2);
  const unsigned km0 = KOFF + (unsigned)(((MSEQ + key0 - PADK) * QLD + h * DK + kc0 * 8) * 2);
  const unsigned vb0 = VOFF + (unsigned)((((b * NH + h) * DV + d0) * 2048 + vc0 * 8) * 2);
  const unsigned vm0 = VMOFF + (unsigned)(((h * DV + d0) * 16 + (vc0 - PADK / 8) * 8) * 2);
  auto issue = [&](int jt, auto sc) {
    constexpr int S = decltype(sc)::value;
    if (jt == 0) {
#pragma unroll
      for (int ps = 0; ps < C::NKL; ++ps) {
        uint4 v = make_uint4(0u, 0u, 0u, 0u);
        if (key0 + ps * (256 / KCH) >= PADK) v = *(const uint4*)(wsb + (km0 + ps * KDELTA));
        pk[S][ps] = v;
      }
#pragma unroll
      for (int ps = 0; ps < C::NVL; ++ps) {
        uint4 v = make_uint4(0u, 0u, 0u, 0u);
        if (vc0 >= PADK / 8) v = *(const uint4*)(wsb + (vm0 + ps * VMDELTA));
        pv[S][ps] = v;
      }
    } else {
      const unsigned kt = kb0 + (unsigned)(jt - 1) * (TK * QLD * 2), vt = vb0 + (unsigned)(jt - 1) * (TK * 2);
#pragma unroll
      for (int ps = 0; ps < C::NKL; ++ps) pk[S][ps] = *(const uint4*)(wsb + (kt + ps * KDELTA));
#pragma unroll
      for (int ps = 0; ps < C::NVL; ++ps) pv[S][ps] = *(const uint4*)(wsb + (vt + ps * VDELTA));
    }
  };
  auto commit = [&](auto bc, auto sc) {
    constexpr int S = decltype(sc)::value;
    char* Ks = smem + decltype(bc)::value * C::STAGE; char* Vs = Ks + TK * KSTR;
#pragma unroll
    for (int ps = 0; ps < C::NKL; ++ps) { const int q = tid + 256 * ps, key = q / KCH, kc = q % KCH; *(uint4*)(Ks + key * KSTR + kc * 16) = pk[S][ps]; }
#pragma unroll
    for (int ps = 0; ps < C::NVL; ++ps) { const int q = tid + 256 * ps, d = q / VCH, kc = q % VCH; *(uint4*)(Vs + d * VSTR + kc * 16) = pv[S][ps]; }
  };
  if (NSET == 2) {
    issue(NT - 1, I0{}); if (NT > 1) issue(NT - 2, std::integral_constant<int, NSET - 1>{});
    commit(I0{}, I0{});
    if (NT > 2) issue(NT - 3, I0{});
  } else {
    issue(NT - 1, I0{}); commit(I0{}, I0{});
    if (NT > 1) issue(NT - 2, I0{});
  }
  __syncthreads();
  auto step = [&](int t, auto sc) {
    constexpr int S = decltype(sc)::value;
    typedef std::integral_constant<int, 1 - S> IN;
    const int jt = NT - 1 - t;
    const char* Ks = smem + S * C::STAGE; const char* Vs = Ks + TK * KSTR;
    const int ek0 = TK * jt;
    if (ek0 <= eq0 + 31) {
      const bool need_mask = (ek0 + TK - 1 > eq0);
      const int eq = eq0 + l32;
      if (FOX) {
        f32x16 st[2];
#pragma unroll
        for (int kb = 0; kb < 2; ++kb) {
#pragma unroll
          for (int s = 0; s < 2; ++s) {
            const float* cp = c2 + ek0 + 32 * kb + 16 * s + 8 * hl;
            const f32x4 ca = *(const f32x4*)cp, cb = *(const f32x4*)(cp + 4);
#pragma unroll
            for (int j = 0; j < 4; ++j) { st[kb][8 * s + j] = ca[j]; st[kb][8 * s + 4 + j] = cb[j]; }
          }
          const char* kp = Ks + (kb * 32 + prow) * KSTR + hl * 16;
#pragma unroll
          for (int ks = 0; ks < NKS; ++ks) { const bf16x8 a = *(const bf16x8*)(kp + ks * 32); st[kb] = MFMA32(a, qf[ks], st[kb]); }
        }
        if (need_mask) {
#pragma unroll
          for (int kb = 0; kb < 2; ++kb)
#pragma unroll
            for (int i = 0; i < 16; ++i) { const int ek = ek0 + 32 * kb + 16 * (i >> 3) + 8 * hl + (i & 7); if (ek > eq) st[kb][i] = -BIG; }
        }
        float mx = -BIG;
#pragma unroll
        for (int kb = 0; kb < 2; ++kb)
#pragma unroll
          for (int i = 0; i < 16; i += 2) mx = fmaxf(fmaxf(mx, st[kb][i]), st[kb][i + 1]);
        mx = xhalf_max(mx);
        const float mnew = fmaxf(mrun, mx);
        if (__any(mnew != mrun)) {
          const float alpha = __builtin_amdgcn_exp2f(mrun - mnew);
          mrun = mnew;
          lrun *= alpha;
#pragma unroll
          for (int mb = 0; mb < NMB; ++mb)
#pragma unroll
            for (int i = 0; i < 16; ++i) O[mb][i] *= alpha;
        }
        f32x2 ps2 = {0.f, 0.f};
        const f32x2 m2 = {mnew, mnew};
#pragma unroll
        for (int kb = 0; kb < 2; ++kb)
#pragma unroll
          for (int i = 0; i < 16; i += 2) {
            f32x2 t = {st[kb][i], st[kb][i + 1]};
            t = t - m2;
            t[0] = __builtin_amdgcn_exp2f(t[0]); t[1] = __builtin_amdgcn_exp2f(t[1]);
            ps2 = ps2 + t;
            st[kb][i] = t[0]; st[kb][i + 1] = t[1];
          }
        lrun += ps2[0] + ps2[1];
        bf16x8 pf[2][2];
#pragma unroll
        for (int kb = 0; kb < 2; ++kb)
#pragma unroll
          for (int s = 0; s < 2; ++s) {
            uint4 u;
            u.x = pack2(st[kb][8 * s + 0], st[kb][8 * s + 1]); u.y = pack2(st[kb][8 * s + 2], st[kb][8 * s + 3]);
            u.z = pack2(st[kb][8 * s + 4], st[kb][8 * s + 5]); u.w = pack2(st[kb][8 * s + 6], st[kb][8 * s + 7]);
            pf[kb][s] = __builtin_bit_cast(bf16x8, u);
          }
#pragma unroll
        for (int mb = 0; mb < NMB; ++mb) {
          const char* vp = Vs + (mb * 32 + l32) * VSTR + hl * 16;
#pragma unroll
          for (int kb = 0; kb < 2; ++kb)
#pragma unroll
            for (int s = 0; s < 2; ++s) { const bf16x8 a = *(const bf16x8*)(vp + kb * 64 + s * 32); O[mb] = MFMA32(a, pf[kb][s], O[mb]); }
        }
      } else {
        f32x16 st = zero16(), st1 = zero16();
        const char* kp = Ks + prow * KSTR + hl * 16;
#pragma unroll
        for (int ks = 0; ks < NKS; ks += 2) {
          const bf16x8 a = *(const bf16x8*)(kp + ks * 32), a1 = *(const bf16x8*)(kp + (ks + 1) * 32);
          st = MFMA32(a, qf[ks], st); st1 = MFMA32(a1, qf[ks + 1], st1);
        }
#pragma unroll
        for (int i = 0; i < 16; ++i) st[i] += st1[i];
        if (need_mask) {
#pragma unroll
          for (int i = 0; i < 16; ++i) { const int ek = ek0 + 16 * (i >> 3) + 8 * hl + (i & 7); if (ek > eq) st[i] = 0.f; }
        }
        bf16x8 pf[2];
#pragma unroll
        for (int s = 0; s < 2; ++s) {
          uint4 u;
          u.x = pack2(st[8 * s + 0], st[8 * s + 1]); u.y = pack2(st[8 * s + 2], st[8 * s + 3]);
          u.z = pack2(st[8 * s + 4], st[8 * s + 5]); u.w = pack2(st[8 * s + 6], st[8 * s + 7]);
          pf[s] = __builtin_bit_cast(bf16x8, u);
        }
#pragma unroll
        for (int mb = 0; mb < NMB; ++mb) {
          const char* vp = Vs + (dh * 128 + mb * 32 + l32) * VSTR + hl * 16;
#pragma unroll
          for (int s = 0; s < 2; ++s) { const bf16x8 a = *(const bf16x8*)(vp + s * 32); O[mb] = MFMA32(a, pf[s], O[mb]); }
        }
      }
    }
    if (t + 1 < NT) {
      typedef std::integral_constant<int, NSET == 2 ? 1 - S : 0> RS;
      commit(IN{}, RS{}); if (t + 1 + NSET < NT) issue(jt - 1 - NSET, RS{});
    }
    __syncthreads();
  };
  for (int t = 0; t < NT; t += 2) {
    step(t, I0{});
    if (t + 1 < NT) step(t + 1, I1{});
  }

  float scale;
  if (FOX) {
    const float lt = xhalf_sum(lrun);
    scale = 1.f / lt;
  } else {
    float ss = 0.f;
#pragma unroll
    for (int mb = 0; mb < NMB; ++mb)
#pragma unroll
      for (int i = 0; i < 16; ++i) ss += O[mb][i] * O[mb][i];
    ss = xhalf_sum(ss);
    if (hl == 0) c2[wave * 32 + l32] = ss;
    __syncthreads();
    ss += c2[(wave ^ 2) * 32 + l32];
    __syncthreads();
    scale = rsqrtf(ss * (1.f / DV) + EPS);
  }
  bf16_t* gp = Gg + (size_t)qrow * 1024 + h * DV + dh * 128 + 8 * hl;
#pragma unroll
  for (int mb = 0; mb < NMB; ++mb)
#pragma unroll
    for (int k = 0; k < 4; k += 2) {
      uint4* a = (uint4*)(gp + mb * 32 + 8 * k);
      const uint4 L = *a;
      auto g0 = __builtin_amdgcn_permlane32_swap(L.x, L.z, false, false);
      auto g1 = __builtin_amdgcn_permlane32_swap(L.y, L.w, false, false);
      uint2 o0, o1;
      o0.x = pack2(O[mb][4 * k] * scale * bflo(g0[0]), O[mb][4 * k + 1] * scale * bfhi(g0[0]));
      o0.y = pack2(O[mb][4 * k + 2] * scale * bflo(g1[0]), O[mb][4 * k + 3] * scale * bfhi(g1[0]));
      o1.x = pack2(O[mb][4 * k + 4] * scale * bflo(g0[1]), O[mb][4 * k + 5] * scale * bfhi(g0[1]));
      o1.y = pack2(O[mb][4 * k + 6] * scale * bflo(g1[1]), O[mb][4 * k + 7] * scale * bfhi(g1[1]));
      auto r0 = __builtin_amdgcn_permlane32_swap(o0.x, o1.x, false, false);
      auto r1 = __builtin_amdgcn_permlane32_swap(o0.y, o1.y, false, false);
      *a = make_uint4(r0[0], r1[0], r0[1], r1[1]);
    }
}

template <bool FOX>
DI void mixer_pair(const Params& p, char* smem, int b, int h, int qa) {
  typedef MixCfg<FOX> C;
  const int tid = threadIdx.x, lane = tid & 63, wave = tid >> 6;
  float* c2 = (float*)(smem + 2 * C::STAGE);
  float* tot = c2 + 2112; float* pre = tot + 64;
  __syncthreads();
  if (FOX) {
    const int n_e = 64 + 128 * (qa + 1);
    const float* LF = (const float*)(p.ws + OFF_LF) + (size_t)(b * 16 + h) * 2048;
    const float* LFM = (const float*)(p.ws + OFF_LFM) + h * 16;
    {
      float raw[9];
#pragma unroll
      for (int k = 0; k < 9; ++k) { const int e = tid + 256 * k; raw[k] = (e >= 48 && e < n_e) ? (e < 64 ? LFM[e - 48] : LF[e - 64]) : 0.f; }
#pragma unroll
      for (int k = 0; k < 9; ++k) { const int e = tid + 256 * k; if (e < n_e) c2[e] = raw[k]; }
    }
    __syncthreads();
    for (int ch = wave; ch * 64 < n_e; ch += 4) {
      const int e = ch * 64 + lane;
      float v = wave_incl_scan(c2[e]);
      c2[e] = v;
      if (lane == 63) tot[ch] = v;
    }
    __syncthreads();
    if (wave == 0) {
      const int nch = n_e >> 6;
      const float t0 = lane < nch ? tot[lane] : 0.f;
      float v = wave_incl_scan(t0);
      pre[lane] = v - t0;
    }
    __syncthreads();
    for (int e = tid; e < n_e; e += 256) c2[e] = e < 48 ? -BIG : -(c2[e] + pre[e >> 6]);
    __syncthreads();
  }
  constexpr int NQ = FOX ? 16 : 32;
  const int flip = blockIdx.x >= (gridDim.x >> 1) ? 1 : 0;
#pragma unroll 1
  for (int s = 0; s < 2; ++s) mixer_sub<FOX>(p, smem, b, h, (s ^ flip) ? NQ - 1 - qa : qa);
}

DI void phase_mixers(const Params& p, char* smem) {
  const int xcd = blockIdx.x & 7, loc = blockIdx.x >> 3, nloc = gridDim.x >> 3;
  for (int i = loc; i < 64; i += nloc) mixer_pair<false>(p, smem, xcd, i >> 4, 31 - (i & 15));
  for (int i = loc; i < 128; i += nloc) mixer_pair<true>(p, smem, xcd, i >> 3, 15 - (i & 7));
}

#define XB_TMO      128
#define XB_XCNT(j)  (256  + 64 * (j))
#define XB_XSUB(j)  (1280 + 64 * (j))
#define XB_XGEN(j)  (2304 + 64 * (j))
#define XB_TOP      3328
#define XB_TOPGEN   3392
#define XCD_BAR_WORDS 3456
#define XB_SPIN_CAP (1u << 22)
DI unsigned xb_ld(unsigned* p) { return __hip_atomic_load(p, __ATOMIC_RELAXED, __HIP_MEMORY_SCOPE_AGENT); }
DI unsigned xb_add(unsigned* p, unsigned v) { return __hip_atomic_fetch_add(p, v, __ATOMIC_RELAXED, __HIP_MEMORY_SCOPE_AGENT); }
DI unsigned xb_xcc_id() { return (unsigned)__builtin_amdgcn_s_getreg((3 << 11) | 20) & 0xFu; }
#define XB_SPIN(cond, bar) do { unsigned _sp = 0; while (cond) { __builtin_amdgcn_s_sleep(1); \
    if ((++_sp & 255u) == 0u) { if (xb_ld(&(bar)[XB_TMO])) break; if (_sp > XB_SPIN_CAP) { atomicAdd(&(bar)[XB_TMO], 1u); break; } } } } while (0)
struct XcdBarrier { unsigned* bar; unsigned x; volatile unsigned* st; };
DI XcdBarrier xcd_barrier_post(unsigned* bar, volatile unsigned* st) {
  XcdBarrier b; b.bar = bar; b.x = xb_xcc_id(); b.st = st;
  if (threadIdx.x == 0) (void)xb_add(&bar[XB_XCNT(b.x)], 1u);
  return b;
}
DI void xcd_barrier_complete(unsigned* bar, unsigned x, unsigned& nloc, unsigned& nx) {
  const unsigned G = gridDim.x;
  unsigned sum, cnt, mine, sp = 0u;
  for (;;) {
    sum = 0u; cnt = 0u; mine = 0u;
#pragma unroll
    for (unsigned j = 0; j < 16; ++j) { const unsigned c = xb_ld(&bar[XB_XCNT(j)]); sum += c; cnt += (c > 0u) ? 1u : 0u; mine = (j == x) ? c : mine; }
    if (sum == G) break;
    __builtin_amdgcn_s_sleep(1);
    if ((++sp & 255u) == 0u) { if (xb_ld(&bar[XB_TMO])) break; if (sp > XB_SPIN_CAP) { atomicAdd(&bar[XB_TMO], 1u); break; } }
  }
  nloc = mine > 0u ? mine : 1u; nx = cnt > 0u ? cnt : 1u;
}
DI void xcd_barrier(const XcdBarrier& b) {
  asm volatile("s_waitcnt vmcnt(0)" ::: "memory");
  __syncthreads();
  if (threadIdx.x == 0) {
    unsigned* bar = b.bar;
    __builtin_amdgcn_s_waitcnt(0);
    unsigned nloc = b.st[0], nx = b.st[1];
    if (nloc == 0u) { xcd_barrier_complete(bar, b.x, nloc, nx); b.st[0] = nloc; b.st[1] = nx; }
    const unsigned old = xb_add(&bar[XB_XSUB(b.x)], 1u);
    const unsigned gen = old / nloc;
    if (old + 1u == (gen + 1u) * nloc) {
      __builtin_amdgcn_fence(__ATOMIC_RELEASE, "agent");
      asm volatile("s_waitcnt vmcnt(0)" ::: "memory");
      const unsigned og = xb_add(&bar[XB_TOP], 1u);
      const unsigned tg = og / nx;
      if (og + 1u == (tg + 1u) * nx) xb_add(&bar[XB_TOPGEN], 1u);
      else XB_SPIN(xb_ld(&bar[XB_TOPGEN]) == tg, bar);
      __builtin_amdgcn_fence(__ATOMIC_ACQUIRE, "agent");
      xb_add(&bar[XB_XGEN(b.x)], 1u);
      asm volatile("s_waitcnt vmcnt(0)" ::: "memory");
    } else {
      XB_SPIN(xb_ld(&bar[XB_XGEN(b.x)]) == gen, bar);
      __builtin_amdgcn_fence(__ATOMIC_ACQUIRE, "agent");
      asm volatile("s_waitcnt vmcnt(0)" ::: "memory");
    }
  }
  __syncthreads();
}

__global__ void __launch_bounds__(256, 2) hymba_fwd(Params p) {
  __shared__ __attribute__((aligned(16))) char smem[SMEM_BYTES];
  __shared__ uint4 xb_words;
  if (threadIdx.x == 0) xb_words = make_uint4(0u, 0u, 0u, 0u);
  __syncthreads();
  const XcdBarrier xb = xcd_barrier_post((unsigned*)(p.ws + OFF_XB), (volatile unsigned*)&xb_words);
  if (p.ws == nullptr) cg::this_grid().sync();
  phase_prep(p, smem);
  xcd_barrier(xb);
  thin_tasks(p);
  gemm_phase<false>(p, smem);
  xcd_barrier(xb);
  phase_mixers(p, smem);
  xcd_barrier(xb);
  gemm_phase<true>(p, smem);
}

extern "C" void kernel_launch(void* const* d_in, const int* in_sizes, int n_in, void* d_out, int out_size, void* d_ws, size_t ws_size, hipStream_t stream) {
  static int grid_blocks = 0;
  if (!grid_blocks) {
    int dev = 0, cus = 0, per_cu = 0;
    hipGetDevice(&dev);
    hipDeviceGetAttribute(&cus, hipDeviceAttributeMultiprocessorCount, dev);
    hipOccupancyMaxActiveBlocksPerMultiprocessor(&per_cu, hymba_fwd, 256, 0);
    if (per_cu > 2) per_cu = 2;
    if (per_cu < 1) per_cu = 1;
    grid_blocks = cus * per_cu;
    grid_blocks &= ~7;
    if (ws_size < WS_END) fprintf(stderr, "workspace too small: %zu < %zu\n", ws_size, (size_t)WS_END);
  }
  Params p{};
  p.x = (const float*)d_in[0]; p.meta = (const float*)d_in[1]; p.norm_g = (const float*)d_in[2]; p.w_in = (const float*)d_in[3];
  p.b_f = (const float*)d_in[4]; p.w_out = (const float*)d_in[5]; p.final_g = (const float*)d_in[6];
  p.out = (float*)d_out; p.ws = (unsigned char*)d_ws;
  hipMemsetAsync((char*)d_ws + OFF_CTR, 0, (OFF_XB - OFF_CTR) + XCD_BAR_WORDS * 4, stream);
  void* args[] = {&p};
  hipError_t e = hipLaunchCooperativeKernel((void*)hymba_fwd, dim3(grid_blocks), dim3(256), args, 0, stream);
  if (e != hipSuccess) fprintf(stderr, "cooperative launch failed: %s (grid %d)\n", hipGetErrorString(e), grid_blocks);
}
```
